# Optimizing an MI355X kernel written in HIP

```python
import jax, jax.numpy as jnp
from jax import lax
import numpy as np

D_MODEL = 2048
BATCH = 8
SEQ = 2048
DEPTH = 2

N_A_LAYERS = DEPTH // 2
N_B_LAYERS = DEPTH - N_A_LAYERS
N_META = 16
D_FF = 5504
ROPE_THETA = 500000.0
ROPE_FRACTION = 4
EPS = 1e-6

A_HEADS = 16
A_KV_HEADS = 4
A_HEAD_DIM = D_MODEL // A_HEADS
IDX_HEADS = 16
IDX_DIM = 64
TOPK_MAX = 256
A_QBLOCK = 64
A_SPLIT_SIZES = (A_HEADS * A_HEAD_DIM, A_KV_HEADS * A_HEAD_DIM, A_KV_HEADS * A_HEAD_DIM, IDX_HEADS * IDX_DIM, IDX_DIM)
A_IN_DIM = sum(A_SPLIT_SIZES) + IDX_HEADS

B_HEADS = 32
B_KV_HEADS = 4
B_HEAD_DIM = D_MODEL // B_HEADS
WINDOW = 128
BLOCK = 128

kernel_name = "yoco_dsa_swa_sink_macaron_hybrid"


def rms_norm(x, g):
    xf = x.astype(jnp.float32)
    y = xf * lax.rsqrt(jnp.mean(xf * xf, axis=-1, keepdims=True) + EPS)
    return (y * g.astype(jnp.float32)).astype(x.dtype)


def partial_rope(x, pos):
    dh = x.shape[-1]
    rot = dh // ROPE_FRACTION
    half = rot // 2
    inv = ROPE_THETA ** (-jnp.arange(half, dtype=jnp.float32) / half)
    ang = pos.astype(jnp.float32)[:, None] * inv[None, :]
    cos = jnp.cos(ang)[:, None, :]
    sin = jnp.sin(ang)[:, None, :]
    xf = x.astype(jnp.float32)
    x1 = xf[..., :half]
    x2 = xf[..., half:rot]
    out = jnp.concatenate([x1 * cos - x2 * sin, x2 * cos + x1 * sin, xf[..., rot:]], axis=-1)
    return out.astype(x.dtype)


def swiglu_half(h, g, w_gate, w_up, w_down):
    n = rms_norm(h, g)
    return h + 0.5 * ((jax.nn.silu(n @ w_gate) * (n @ w_up)) @ w_down)


def indexer_sparse_attention(hn, pos, w_in, q_norm, k_norm, idx_k_norm, w_out, topk):
    bsz, t_len, _ = hn.shape
    proj = hn @ w_in
    q, k, v, qi, ki, wi = jnp.split(proj, np.cumsum(A_SPLIT_SIZES).tolist(), axis=-1)
    q = partial_rope(rms_norm(q.reshape(bsz, t_len, A_HEADS, A_HEAD_DIM), q_norm), pos)
    k = partial_rope(rms_norm(k.reshape(bsz, t_len, A_KV_HEADS, A_HEAD_DIM), k_norm), pos)
    v = v.reshape(bsz, t_len, A_KV_HEADS, A_HEAD_DIM)
    qi = partial_rope(qi.reshape(bsz, t_len, IDX_HEADS, IDX_DIM), pos)
    ki = partial_rope(rms_norm(ki, idx_k_norm)[:, :, None, :], pos)[:, :, 0, :].astype(jnp.float32)
    wi = wi.astype(jnp.float32) * (IDX_HEADS * IDX_DIM) ** -0.5
    group = A_HEADS // A_KV_HEADS
    scale = A_HEAD_DIM ** -0.5
    nb = t_len // A_QBLOCK

    def to_blocks(a):
        return jnp.moveaxis(a.reshape(bsz, nb, A_QBLOCK, *a.shape[2:]), 1, 0)

    def block(args):
        qb, qib, wib, qp = args
        s_idx = jnp.einsum('bqhd,bsd->bqhs', qib.astype(jnp.float32), ki)
        score = jnp.einsum('bqhs,bqh->bqs', jax.nn.relu(s_idx), wib)
        causal = pos[None, :] <= qp[:, None]
        score = jnp.where(causal[None], score, -jnp.inf)
        _, sel = lax.top_k(score, topk)
        kg = jax.vmap(lambda kb, ib: kb[ib])(k, sel)
        vg = jax.vmap(lambda vb, ib: vb[ib])(v, sel)
        qg = qb.reshape(bsz, A_QBLOCK, A_KV_HEADS, group, A_HEAD_DIM)
        logits = jnp.einsum('bqngd,bqknd->bqngk', qg, kg).astype(jnp.float32) * scale
        valid = pos[sel] <= qp[None, :, None]
        logits = jnp.where(valid[:, :, None, None, :], logits, -jnp.inf)
        p = jax.nn.softmax(logits, axis=-1).astype(vg.dtype)
        o = jnp.einsum('bqngk,bqknd->bqngd', p, vg)
        return o.reshape(bsz, A_QBLOCK, A_HEADS * A_HEAD_DIM)

    out = lax.map(block, (to_blocks(q), to_blocks(qi), to_blocks(wi), pos.reshape(nb, A_QBLOCK)))
    out = jnp.moveaxis(out, 0, 1).reshape(bsz, t_len, A_HEADS * A_HEAD_DIM)
    return out @ w_out


def shared_kv(hn, pos, w_kv, k_norm):
    bsz, t_len, _ = hn.shape
    k, v = jnp.split(hn @ w_kv, 2, axis=-1)
    k = partial_rope(rms_norm(k.reshape(bsz, t_len, B_KV_HEADS, B_HEAD_DIM), k_norm), pos)
    v = v.reshape(bsz, t_len, B_KV_HEADS, B_HEAD_DIM)
    return k, v


def sliding_window_sink_attention(hn, pos, k, v, w_q, q_norm, sinks, w_out):
    bsz, t_len, _ = hn.shape
    group = B_HEADS // B_KV_HEADS
    scale = B_HEAD_DIM ** -0.5
    nb = t_len // BLOCK
    q = partial_rope(rms_norm((hn @ w_q).reshape(bsz, t_len, B_HEADS, B_HEAD_DIM), q_norm), pos)
    qb = jnp.moveaxis(q.reshape(bsz, nb, BLOCK, B_KV_HEADS, group, B_HEAD_DIM), 1, 0)
    kb = k.reshape(bsz, nb, BLOCK, B_KV_HEADS, B_HEAD_DIM)
    vb = v.reshape(bsz, nb, BLOCK, B_KV_HEADS, B_HEAD_DIM)
    pad = ((0, 0), (1, 0), (0, 0), (0, 0), (0, 0))
    kw = jnp.moveaxis(jnp.concatenate([jnp.pad(kb[:, :-1], pad), kb], axis=2), 1, 0)
    vw = jnp.moveaxis(jnp.concatenate([jnp.pad(vb[:, :-1], pad), vb], axis=2), 1, 0)
    c = jnp.arange(nb)[:, None, None]
    r = jnp.arange(BLOCK)[None, :, None]
    j = jnp.arange(2 * BLOCK)[None, None, :]
    rel = BLOCK + r - j
    mask = (rel >= 0) & (rel < WINDOW) & ((c > 0) | (j >= BLOCK))
    sink = sinks.astype(jnp.float32).reshape(1, B_KV_HEADS, group, 1, 1)

    def block(args):
        qc, kc, vc, mc = args
        logits = jnp.einsum('bqngd,bknd->bngqk', qc, kc).astype(jnp.float32) * scale
        logits = jnp.where(mc[None, None, None], logits, -jnp.inf)
        m = jnp.maximum(jnp.max(logits, axis=-1, keepdims=True), sink)
        e = jnp.exp(logits - m)
        p = e / (jnp.sum(e, axis=-1, keepdims=True) + jnp.exp(sink - m))
        return jnp.einsum('bngqk,bknd->bqngd', p.astype(vc.dtype), vc)

    out = lax.map(block, (qb, kw, vw, mask))
    out = jnp.moveaxis(out, 0, 1).reshape(bsz, t_len, B_HEADS * B_HEAD_DIM)
    return out @ w_out


def setup_inputs(seed: int = 0) -> dict:
    key = jax.random.key(seed)
    ks = iter(jax.random.split(key, 40))

    def nrm(shape, scale):
        return jax.random.normal(next(ks), shape, jnp.float32) * scale

    def gain(shape):
        return 1.0 + 0.02 * jax.random.normal(next(ks), shape, jnp.float32)

    d = D_MODEL
    return {
        "x": nrm((BATCH, SEQ, d), 1.0),
        "meta_tokens": nrm((N_META, d), 1.0),
        "ffn1_norm": gain((DEPTH, d)),
        "ffn1_w_gate": nrm((DEPTH, d, D_FF), d ** -0.5),
        "ffn1_w_up": nrm((DEPTH, d, D_FF), d ** -0.5),
        "ffn1_w_down": nrm((DEPTH, D_FF, d), D_FF ** -0.5),
        "ffn2_norm": gain((DEPTH, d)),
        "ffn2_w_gate": nrm((DEPTH, d, D_FF), d ** -0.5),
        "ffn2_w_up": nrm((DEPTH, d, D_FF), d ** -0.5),
        "ffn2_w_down": nrm((DEPTH, D_FF, d), D_FF ** -0.5),
        "a_norm": gain((N_A_LAYERS, d)),
        "a_w_in": nrm((N_A_LAYERS, d, A_IN_DIM), d ** -0.5),
        "a_q_norm": gain((N_A_LAYERS, A_HEAD_DIM)),
        "a_k_norm": gain((N_A_LAYERS, A_HEAD_DIM)),
        "a_idx_k_norm": gain((N_A_LAYERS, IDX_DIM)),
        "a_w_out": nrm((N_A_LAYERS, A_HEADS * A_HEAD_DIM, d), (A_HEADS * A_HEAD_DIM) ** -0.5),
        "kv_norm": gain((d,)),
        "kv_w": nrm((d, 2 * B_KV_HEADS * B_HEAD_DIM), d ** -0.5),
        "kv_k_norm": gain((B_HEAD_DIM,)),
        "b_norm": gain((N_B_LAYERS, d)),
        "b_w_q": nrm((N_B_LAYERS, d, B_HEADS * B_HEAD_DIM), d ** -0.5),
        "b_q_norm": gain((N_B_LAYERS, B_HEAD_DIM)),
        "b_sinks": nrm((N_B_LAYERS, B_HEADS), 1.0),
        "b_w_out": nrm((N_B_LAYERS, B_HEADS * B_HEAD_DIM, d), (B_HEADS * B_HEAD_DIM) ** -0.5),
    }


def reference(x, meta_tokens, ffn1_norm, ffn1_w_gate, ffn1_w_up, ffn1_w_down, ffn2_norm, ffn2_w_gate, ffn2_w_up, ffn2_w_down, a_norm, a_w_in, a_q_norm, a_k_norm, a_idx_k_norm, a_w_out, kv_norm, kv_w, kv_k_norm, b_norm, b_w_q, b_q_norm, b_sinks, b_w_out):
    bsz, s_len, _ = x.shape
    topk = min(TOPK_MAX, s_len // 4)
    t_real = s_len + N_META
    t_len = -(-t_real // BLOCK) * BLOCK
    meta = jnp.broadcast_to(meta_tokens[None].astype(x.dtype), (bsz, N_META, D_MODEL))
    h = jnp.concatenate([meta, x, jnp.zeros((bsz, t_len - t_real, D_MODEL), x.dtype)], axis=1)
    pos = jnp.arange(t_len, dtype=jnp.int32)
    k_sh = v_sh = None
    for layer in range(DEPTH):
        if layer == N_A_LAYERS:
            k_sh, v_sh = shared_kv(rms_norm(h, kv_norm), pos, kv_w, kv_k_norm)
        h = swiglu_half(h, ffn1_norm[layer], ffn1_w_gate[layer], ffn1_w_up[layer], ffn1_w_down[layer])
        if layer < N_A_LAYERS:
            i = layer
            h = h + indexer_sparse_attention(rms_norm(h, a_norm[i]), pos, a_w_in[i], a_q_norm[i], a_k_norm[i], a_idx_k_norm[i], a_w_out[i], topk)
        else:
            i = layer - N_A_LAYERS
            h = h + sliding_window_sink_attention(rms_norm(h, b_norm[i]), pos, k_sh, v_sh, b_w_q[i], b_q_norm[i], b_sinks[i], b_w_out[i])
        h = swiglu_half(h, ffn2_norm[layer], ffn2_w_gate[layer], ffn2_w_up[layer], ffn2_w_down[layer])
    return h[:, N_META:N_META + s_len]
```

```cpp
#include <hip/hip_runtime.h>
#include <hip/hip_cooperative_groups.h>
#include <cstdio>
#include <cstdint>
#include <cmath>
namespace cg = cooperative_groups;
namespace pg8 {
#define PG8_LAS __attribute__((address_space(3)))
typedef unsigned short bf16_t;
typedef short bf16x8 __attribute__((ext_vector_type(8)));
typedef float f32x4 __attribute__((ext_vector_type(4)));
typedef unsigned u32x4 __attribute__((ext_vector_type(4)));
constexpr int BM = 256, BK = 64, HALF = 128, HTB = HALF * BK * 2  , STAGE_BYTES = 8 * HTB, NXCD = 8, WGM = 8;

__host__ __device__ __forceinline__ int lds_byte(int r, int c) { const int st = (r >> 4) * 2 + (c >> 5), rr = r & 15, cc = c & 31, ob = rr * 64 + cc * 2; return st * 1024 + (ob ^ (((ob >> 9) & 1) << 5)); }
__host__ __device__ __forceinline__ void stage_rc(int b, int& R, int& C) { const int st = b / 1024, sb = b % 1024, swz = sb ^ (((sb >> 9) & 1) << 5); R = (st >> 1) * 16 + swz / 64; C = (st & 1) * 32 + (swz % 64) / 2; }
__host__ __device__ __forceinline__ int perm32(int rho) { const int n = rho >> 4, i = rho & 15; return 8 * (i >> 2) + 4 * n + (i & 3); }

struct Unit { int pm, pn, k0, nt; };
struct Gemm { const bf16_t* A; const bf16_t* Bt; int M, N, K; };

struct StaticOrder {
    int nM, nN, nwg, G, c, ntf;
    __host__ __device__ __forceinline__ void init(int M, int N, int G_, int c_, int K_ = 0) { nM = M / BM; nN = N / BM; nwg = nM * nN; G = G_; c = c_; ntf = K_ / BK; }
    __host__ __device__ __forceinline__ bool next(int i, Unit& u) const {
        const long L = (long)i * G + c; if (L >= nwg) return false;
        int wgid = (int)L; { const int q = nwg / NXCD, r = nwg % NXCD, xcd = wgid % NXCD, off = wgid / NXCD; wgid = (xcd < r ? xcd * (q + 1) : r * (q + 1) + (xcd - r) * q) + off; }
        const int nig = WGM * nN, gid = wgid / nig, fm = gid * WGM, gsz = (nM - fm) < WGM ? (nM - fm) : WGM;
        u.pm = fm + ((wgid % nig) % gsz); u.pn = (wgid % nig) / gsz; u.k0 = 0; u.nt = ntf; return true;
    }
    __device__ __forceinline__ void a_ready(const Unit&) const {}
    __device__ __forceinline__ void done(const Unit&) const {}
};

__device__ __forceinline__ unsigned cvt_pk_bf16(float lo, float hi) { unsigned r; asm volatile("v_cvt_pk_bf16_f32 %0, %1, %2" : "=v"(r) : "v"(lo), "v"(hi)); return r; }
typedef float f32x2 __attribute__((ext_vector_type(2)));
template <class Epi, class Sched, bool ALIGN_EPI = false, bool SP2 = false>
__device__ __forceinline__ void gemm_phase(PG8_LAS unsigned char* lds, const Gemm g, const Sched& S, const Epi& E) {
    int tid_l = threadIdx.x; asm volatile("" : "+v"(tid_l));
    const int tid = tid_l, wid = __builtin_amdgcn_readfirstlane(tid >> 6), lane = tid & 63, wr = wid >> 2, wc = wid & 3, fr = lane & 15, fq = lane >> 4;
    const int K = g.K;
    unsigned voffA[2], voffB[2];
#pragma unroll
    for (int i = 0; i < 2; ++i) { int R, C; stage_rc(tid * 16 + i * 8192, R, C); const int Rb = Epi::PERM ? ((R & ~31) + perm32(R & 31)) : R;
        voffA[i] = (unsigned)(R * K + C) * 2u; voffB[i] = (unsigned)(Rb * K + C) * 2u; }
    const size_t kstep = (size_t)(BK * 2);
    const size_t hstep = (size_t)HALF * K * 2;
    const size_t tstep = 2 * hstep;
    const unsigned ldsw = (unsigned)wid * 1024u;
    const int aoff = lds_byte(wr * 64 + fr, fq * 8), boff = lds_byte(wc * 32 + fr, fq * 8);
#define PG8_SA(b, h) (((b) * 2 + (h)) * HTB)
#define PG8_SB(b, h) ((4 + (b) * 2 + (h)) * HTB)
#define PG8_STAGE(bufoff, gbase, voff) do { _Pragma("unroll") for (int _i = 0; _i < 2; ++_i) \
        __builtin_amdgcn_global_load_lds((const unsigned*)((const char*)(gbase) + (voff)[_i]), (PG8_LAS unsigned*)(lds + (bufoff) + ldsw + _i * 8192), 16, 0, 0); } while (0)
#define PG8_STAGE_A(bufoff, gbase, voff) do { _Pragma("unroll") for (int _i = 0; _i < 2; ++_i) \
        __builtin_amdgcn_global_load_lds((const unsigned*)((const char*)(gbase) + (voff)[_i]), (PG8_LAS unsigned*)(lds + (bufoff) + ldsw + _i * 8192), 16, 0, Epi::A_AUX); } while (0)
#define PG8_LDA(dst, b, h) do { _Pragma("unroll") for (int m = 0; m < 4; ++m) _Pragma("unroll") for (int k = 0; k < 2; ++k) dst[m][k] = *(const PG8_LAS bf16x8*)(lds + PG8_SA(b, h) + aoff + m * 2048 + k * 1024); } while (0)
#define PG8_LDB(dst, b, h) do { _Pragma("unroll") for (int n = 0; n < 2; ++n) _Pragma("unroll") for (int k = 0; k < 2; ++k) dst[n][k] = *(const PG8_LAS bf16x8*)(lds + PG8_SB(b, h) + boff + n * 2048 + k * 1024); } while (0)
#define PG8_MMA(ai, bj, At, Bt) do { __builtin_amdgcn_s_setprio(1); _Pragma("unroll") for (int m = 0; m < 4; ++m) _Pragma("unroll") for (int n = 0; n < 2; ++n) _Pragma("unroll") for (int k = 0; k < 2; ++k) \
        acc[ai][bj][m][n] = __builtin_amdgcn_mfma_f32_16x16x32_bf16(Bt[n][k], At[m][k], acc[ai][bj][m][n], 0, 0, 0); __builtin_amdgcn_s_setprio(0); } while (0)
#define PG8_WAIT_V(n) asm volatile("s_waitcnt vmcnt(" #n ")" ::: "memory")
#define PG8_WAIT_L(n) asm volatile("s_waitcnt lgkmcnt(" #n ")" ::: "memory")
#define PG8_BAR __builtin_amdgcn_s_barrier()
#define PG8_SCHED __builtin_amdgcn_sched_barrier(0)
    Unit cur, nxt; int ui = 0;
    if (!S.next(0, cur)) return;
    f32x4 acc[2][2][4][2];
#pragma unroll
    for (int a = 0; a < 2; ++a)
#pragma unroll
        for (int b = 0; b < 2; ++b)
#pragma unroll
            for (int m = 0; m < 4; ++m)
#pragma unroll
                for (int n = 0; n < 2; ++n) acc[a][b][m][n] = (f32x4){0.f, 0.f, 0.f, 0.f};
    bf16x8 At[4][2], B0[2][2], B1[2][2];
    const char* cA = (const char*)g.A + (size_t)cur.pm * tstep + (size_t)cur.k0 * kstep; const char* cB = (const char*)g.Bt + (size_t)cur.pn * tstep + (size_t)cur.k0 * kstep;
    S.a_ready(cur);
    if constexpr (SP2) {
        PG8_STAGE(PG8_SB(0, 0), cB, voffB); PG8_STAGE(PG8_SB(0, 1), cB + hstep, voffB); PG8_STAGE_A(PG8_SA(0, 0), cA, voffA); PG8_STAGE_A(PG8_SA(0, 1), cA + hstep, voffA);
        if (wr == 1) PG8_BAR;
        PG8_WAIT_V(2); PG8_BAR;
        PG8_STAGE(PG8_SB(1, 0), cB + kstep, voffB); PG8_STAGE_A(PG8_SA(1, 0), cA + kstep, voffA); PG8_STAGE(PG8_SB(1, 1), cB + hstep + kstep, voffB);
        PG8_WAIT_V(6); PG8_BAR;
    } else {
        PG8_STAGE(PG8_SB(0, 0), cB, voffB); PG8_STAGE_A(PG8_SA(0, 0), cA, voffA); PG8_STAGE(PG8_SB(0, 1), cB + hstep, voffB); PG8_STAGE_A(PG8_SA(0, 1), cA + hstep, voffA);
        if (wr == 1) PG8_BAR;
        PG8_WAIT_V(4); PG8_BAR;
        PG8_STAGE(PG8_SB(1, 0), cB + kstep, voffB); PG8_STAGE_A(PG8_SA(1, 0), cA + kstep, voffA); PG8_STAGE(PG8_SB(1, 1), cB + hstep + kstep, voffB);
        PG8_WAIT_V(6); PG8_BAR;
    }
    for (;;) {
        const bool has_next = S.next(ui + 1, nxt);
        const char* nA = has_next ? (const char*)g.A + (size_t)nxt.pm * tstep + (size_t)nxt.k0 * kstep : cA; const char* nB = has_next ? (const char*)g.Bt + (size_t)nxt.pn * tstep + (size_t)nxt.k0 * kstep : cB;
        const int nt = cur.nt;
        for (int t = 0; t < nt; t += 2) {
            const bool last = (t == nt - 2);
            const char* a1 = cA + (size_t)(t + 1) * kstep;
            const char* a2 = last ? nA : cA + (size_t)(t + 2) * kstep; const char* b2 = last ? nB : cB + (size_t)(t + 2) * kstep;
            const char* a3 = a2 + kstep; const char* b3 = b2 + kstep;
            if (last && has_next) S.a_ready(nxt);
            if constexpr (SP2) {
            PG8_LDB(B0, 0, 0); PG8_LDB(B1, 0, 1); PG8_SCHED; PG8_LDA(At, 0, 0); PG8_STAGE_A(PG8_SA(1, 1), a1 + hstep, voffA);
            PG8_WAIT_V(8); PG8_WAIT_L(0); PG8_BAR; PG8_MMA(0, 0, At, B0); PG8_MMA(0, 1, At, B1); PG8_BAR; PG8_SCHED;
            PG8_LDA(At, 0, 1); PG8_STAGE(PG8_SB(0, 0), b2, voffB); PG8_STAGE(PG8_SB(0, 1), b2 + hstep, voffB); PG8_STAGE_A(PG8_SA(0, 0), a2, voffA);
            PG8_WAIT_V(8); PG8_WAIT_L(0); PG8_BAR; PG8_MMA(1, 0, At, B0); PG8_MMA(1, 1, At, B1); PG8_BAR; PG8_SCHED;
            PG8_LDB(B0, 1, 0); PG8_LDB(B1, 1, 1); PG8_SCHED; PG8_LDA(At, 1, 0); PG8_STAGE_A(PG8_SA(0, 1), a2 + hstep, voffA);
            PG8_WAIT_V(8); PG8_WAIT_L(0); PG8_BAR; PG8_MMA(0, 0, At, B0); PG8_MMA(0, 1, At, B1); PG8_BAR; PG8_SCHED;
            PG8_LDA(At, 1, 1); PG8_STAGE(PG8_SB(1, 0), b3, voffB); PG8_STAGE(PG8_SB(1, 1), b3 + hstep, voffB); PG8_STAGE_A(PG8_SA(1, 0), a3, voffA);
            PG8_WAIT_V(8); PG8_WAIT_L(0); PG8_BAR; PG8_MMA(1, 0, At, B0); PG8_MMA(1, 1, At, B1); PG8_BAR; PG8_SCHED;
            } else {
            PG8_LDB(B0, 0, 0); PG8_SCHED; PG8_LDA(At, 0, 0); PG8_STAGE_A(PG8_SA(1, 1), a1 + hstep, voffA);
            PG8_WAIT_L(8); PG8_BAR; PG8_WAIT_L(0); PG8_MMA(0, 0, At, B0); PG8_BAR; PG8_SCHED;
            PG8_LDB(B1, 0, 1); PG8_STAGE(PG8_SB(0, 0), b2, voffB);
            PG8_BAR; PG8_WAIT_L(0); PG8_MMA(0, 1, At, B1); PG8_BAR;
            PG8_LDA(At, 0, 1); PG8_STAGE_A(PG8_SA(0, 0), a2, voffA);
            PG8_BAR; PG8_WAIT_L(0); PG8_MMA(1, 0, At, B0); PG8_BAR; PG8_SCHED;
            PG8_STAGE(PG8_SB(0, 1), b2 + hstep, voffB);
            PG8_WAIT_V(6); PG8_BAR; PG8_MMA(1, 1, At, B1); PG8_BAR;
            PG8_LDB(B0, 1, 0); PG8_SCHED; PG8_LDA(At, 1, 0); PG8_STAGE_A(PG8_SA(0, 1), a2 + hstep, voffA);
            PG8_WAIT_L(8); PG8_BAR; PG8_WAIT_L(0); PG8_MMA(0, 0, At, B0); PG8_BAR; PG8_SCHED;
            PG8_LDB(B1, 1, 1); PG8_STAGE(PG8_SB(1, 0), b3, voffB);
            PG8_BAR; PG8_WAIT_L(0); PG8_MMA(0, 1, At, B1); PG8_BAR;
            PG8_LDA(At, 1, 1); PG8_STAGE_A(PG8_SA(1, 0), a3, voffA);
            PG8_BAR; PG8_WAIT_L(0); PG8_MMA(1, 0, At, B0); PG8_BAR; PG8_SCHED;
            PG8_STAGE(PG8_SB(1, 1), b3 + hstep, voffB);
            PG8_WAIT_V(6); PG8_BAR; PG8_MMA(1, 1, At, B1); PG8_BAR;
            }
        }
        if constexpr (ALIGN_EPI) { if (wr == 0) PG8_BAR; }
        if constexpr (!Epi::AFTER_DRAIN) { E(acc, cur, wr, wc, fr, fq); S.done(cur); }
        if (!has_next) break;
#pragma unroll
        for (int a = 0; a < 2; ++a)
#pragma unroll
            for (int b = 0; b < 2; ++b)
#pragma unroll
                for (int m = 0; m < 4; ++m)
#pragma unroll
                    for (int n = 0; n < 2; ++n) acc[a][b][m][n] = (f32x4){0.f, 0.f, 0.f, 0.f};
        cur = nxt; cA = nA; cB = nB; ++ui;
        if constexpr (ALIGN_EPI) { if (wr == 1) PG8_BAR; }
    }
    PG8_WAIT_V(0);
    if constexpr (!ALIGN_EPI) { if (wr == 0) PG8_BAR; }
    PG8_BAR;
    if constexpr (Epi::AFTER_DRAIN) { E.fused(acc, cur, wr, wc, fr, fq, lds, wid, lane); S.done(cur); }
#undef PG8_SA
#undef PG8_SB
#undef PG8_STAGE
#undef PG8_STAGE_A
#undef PG8_LDA
#undef PG8_LDB
#undef PG8_MMA
#undef PG8_WAIT_V
#undef PG8_WAIT_L
#undef PG8_BAR
#undef PG8_SCHED
}
}
namespace pg8 {
typedef unsigned u32x2 __attribute__((ext_vector_type(2)));
__device__ __forceinline__ unsigned pk_bf16(float lo, float hi) {
    typedef float f2_t __attribute__((ext_vector_type(2))); typedef __bf16 b2_t __attribute__((ext_vector_type(2)));
    f2_t v = {lo, hi}; b2_t b = __builtin_convertvector(v, b2_t); return __builtin_bit_cast(unsigned, b);
}
constexpr int E_T = 2064, E_M = 8 * 2064, E_DM = 2048, E_DFF = 5504;
struct EpiSwiglu {
    static constexpr bool PERM = true, AFTER_DRAIN = false; static constexpr int A_AUX = 0;
    bf16_t* act; const float* ss; long long skip;
    __device__ __forceinline__ void operator()(const f32x4 (&acc)[2][2][4][2], const Unit& u, int wr, int wc, int fr, int fq) const {
        if (skip) return;
        const int row0 = u.pm * BM + wr * 64 + fr; const int col0 = u.pn * 128 + wc * 32 + 8 * fq;
        float rs[2][4];
#pragma unroll
        for (int ai = 0; ai < 2; ++ai)
#pragma unroll
            for (int m = 0; m < 4; ++m) rs[ai][m] = ss[row0 + ai * HALF + m * 16];
#pragma unroll
        for (int ai = 0; ai < 2; ++ai)
#pragma unroll
            for (int m = 0; m < 4; ++m) {
                const int row = row0 + ai * HALF + m * 16;
                const float r = __builtin_amdgcn_rsqf(rs[ai][m] * (1.0f / 2048.0f) + 1e-6f);
                float o[8];
#pragma unroll
                for (int n = 0; n < 2; ++n)
#pragma unroll
                    for (int j = 0; j < 4; ++j) {
                        const float g = acc[ai][0][m][n][j] * r, up = acc[ai][1][m][n][j] * r;
                        const float sg = g * __builtin_amdgcn_rcpf(1.0f + __builtin_amdgcn_exp2f(-1.4426950408889634f * g));
                        o[n * 4 + j] = sg * up;
                    }
                u32x4 w; w.x = pk_bf16(o[0], o[1]); w.y = pk_bf16(o[2], o[3]); w.z = pk_bf16(o[4], o[5]); w.w = pk_bf16(o[6], o[7]);
                *(u32x4*)(act + (size_t)row * E_DFF + col0) = w;
            }
    }
};
struct EpiResid {
    static constexpr bool PERM = true, AFTER_DRAIN = false; static constexpr int A_AUX = 0;
    bf16_t* hb; float* ss_out; float* dout; float* part; float alpha; int ch;
    __device__ __forceinline__ void operator()(const f32x4 (&acc)[2][2][4][2], const Unit& u, int wr, int wc, int fr, int fq) const {
        const int row0 = u.pm * BM + wr * 64 + fr; const int col0 = u.pn * BM + wc * 32 + 8 * fq;
        if (u.pm == 64) {
            float* pp = part + ((size_t)(u.k0 / ch) * 128 + wr * 64 + fr) * E_DM + col0;
#pragma unroll
            for (int m = 0; m < 4; ++m)
#pragma unroll
                for (int bj = 0; bj < 2; ++bj)
#pragma unroll
                    for (int n = 0; n < 2; ++n) *(f32x4*)(pp + (size_t)(m * 16) * E_DM + bj * HALF + n * 4) = acc[0][bj][m][n];
            return;
        }
#pragma unroll
        for (int ai = 0; ai < 2; ++ai) {
            u32x4 hwa[4][2];
#pragma unroll
            for (int m = 0; m < 4; ++m)
#pragma unroll
                for (int bj = 0; bj < 2; ++bj) hwa[m][bj] = *(const u32x4*)(hb + (size_t)(row0 + ai * HALF + m * 16) * E_DM + col0 + bj * HALF);
            asm volatile("" ::: "memory");
#pragma unroll
            for (int m = 0; m < 4; ++m) {
                const int row = row0 + ai * HALF + m * 16; const size_t off = (size_t)row * E_DM + col0;
                u32x4 hw[2];
#pragma unroll
                for (int bj = 0; bj < 2; ++bj) hw[bj] = hwa[m][bj];
                f32x4 v[2][2];
#pragma unroll
                for (int bj = 0; bj < 2; ++bj)
#pragma unroll
                    for (int n = 0; n < 2; ++n) { const unsigned w0 = hw[bj][2 * n], w1 = hw[bj][2 * n + 1];
                        const f32x4 hv = (f32x4){__uint_as_float(w0 << 16), __uint_as_float(w0 & 0xffff0000u), __uint_as_float(w1 << 16), __uint_as_float(w1 & 0xffff0000u)};
                        v[bj][n] = hv + acc[ai][bj][m][n] * alpha; }
                if (dout) {
                    const int b = row / E_T, t = row - b * E_T;
                    if (t >= 16 && row < E_M) { float* d = dout + ((size_t)(b * 2048 + t - 16)) * E_DM + col0;
#pragma unroll
                        for (int bj = 0; bj < 2; ++bj)
#pragma unroll
                            for (int n = 0; n < 2; ++n) *(f32x4*)(d + bj * HALF + n * 4) = v[bj][n]; }
                } else {
                    float sq = 0.f;
#pragma unroll
                    for (int bj = 0; bj < 2; ++bj) { const f32x4 x = v[bj][0], y = v[bj][1];
                        u32x4 w; w.x = pk_bf16(x[0], x[1]); w.y = pk_bf16(x[2], x[3]); w.z = pk_bf16(y[0], y[1]); w.w = pk_bf16(y[2], y[3]); *(u32x4*)(hb + off + bj * HALF) = w;
                        sq += ((x[0] * x[0] + x[1] * x[1]) + (x[2] * x[2] + x[3] * x[3])) + ((y[0] * y[0] + y[1] * y[1]) + (y[2] * y[2] + y[3] * y[3])); }
                    sq += __shfl_xor(sq, 16); sq += __shfl_xor(sq, 32);
                    if (fq == 0) atomicAdd(ss_out + row, sq);
                }
            }
            asm volatile("" ::: "memory");
        }
    }
};
struct EpiScale {
    static constexpr bool PERM = false, AFTER_DRAIN = false; static constexpr int A_AUX = 0;
    bf16_t* pb; float* pf; const float* ss; int ldb, nbf, ldf, pad_;
    __device__ __forceinline__ void operator()(const f32x4 (&acc)[2][2][4][2], const Unit& u, int wr, int wc, int fr, int fq) const {
        const int row0 = u.pm * BM + wr * 64 + fr; const int col0 = wc * 32 + 4 * fq;
        float rs[2][4];
#pragma unroll
        for (int ai = 0; ai < 2; ++ai)
#pragma unroll
            for (int m = 0; m < 4; ++m) rs[ai][m] = ss[row0 + ai * HALF + m * 16];
#pragma unroll
        for (int ai = 0; ai < 2; ++ai)
#pragma unroll
            for (int m = 0; m < 4; ++m) {
                const int row = row0 + ai * HALF + m * 16;
                const float r = __builtin_amdgcn_rsqf(rs[ai][m] * (1.0f / 2048.0f) + 1e-6f);
                if (u.pn < nbf) { bf16_t* p = pb + (size_t)row * ldb + u.pn * BM + col0;
#pragma unroll
                    for (int bj = 0; bj < 2; ++bj)
#pragma unroll
                        for (int n = 0; n < 2; ++n) { const f32x4 x = acc[ai][bj][m][n] * r; u32x2 w; w.x = pk_bf16(x[0], x[1]); w.y = pk_bf16(x[2], x[3]); *(u32x2*)(p + bj * HALF + n * 16) = w; }
                } else { float* p = pf + (size_t)row * ldf + (u.pn - nbf) * BM + col0;
#pragma unroll
                    for (int bj = 0; bj < 2; ++bj)
#pragma unroll
                        for (int n = 0; n < 2; ++n) *(f32x4*)(p + bj * HALF + n * 16) = acc[ai][bj][m][n] * r;
                }
            }
    }
};
struct ResidOrder {
    StaticOrder so; int G, c, ntf, ch, nch;
    __device__ __forceinline__ void init(int K, int G_, int c_) { so.init(16384, 2048, G_, c_, K); G = G_; c = c_; ntf = K / BK; ch = 4; nch = (ntf + ch - 1) / ch; }
    __device__ __forceinline__ bool next(int i, Unit& u) const {
        const int L = i * G + c;
        if (L < 512) return so.next(i, u);
        const int p = L - 512; if (p >= 8 * nch) return false;
        u.pm = 64; u.pn = p & 7; const int chunk = p >> 3; u.k0 = chunk * ch; u.nt = (ntf - u.k0) < ch ? (ntf - u.k0) : ch; return true;
    }
    __device__ __forceinline__ void a_ready(const Unit&) const {}
    __device__ __forceinline__ void done(const Unit&) const {}
};
}
#define DI __device__ __forceinline__
#define LAS __attribute__((address_space(3)))
#define GAS __attribute__((address_space(1)))
typedef unsigned short bf16_t;
typedef short bf16x8 __attribute__((ext_vector_type(8)));
typedef float f32x4 __attribute__((ext_vector_type(4)));
typedef float f32x16 __attribute__((ext_vector_type(16)));
typedef unsigned u32x4 __attribute__((ext_vector_type(4)));
typedef unsigned u32x2 __attribute__((ext_vector_type(2)));
typedef unsigned long long u64;
using pg8::pk_bf16;

constexpr int NB = 8, DM = 2048, T = 2064, M = NB * T, MP = 16640, DFF = 5504, TP = 2112;
constexpr int AINP = 4352, MW = 66;
constexpr float EPS = 1e-6f;
constexpr float QSCALE_A = 0.12751743082459868f;
constexpr float QSCALE_B = 0.18033688011112042f;
constexpr float LOG2E = 1.4426950408889634f;
constexpr int NWAVES = 8, LDS_BYTES = 147456, PTRTAB_OFF = LDS_BYTES - 256;

constexpr size_t al256(size_t x) { return (x + 255) & ~(size_t)255; }
constexpr size_t SZ_WGU = (size_t)11008 * 2048 * 2, SZ_WD = (size_t)2048 * 5504 * 2, SZ_SQ = (size_t)2048 * 2048 * 2;
constexpr size_t O_SS = 0;
constexpr size_t O_WGU_A = al256(O_SS + (size_t)8 * MP * 4);
constexpr size_t O_WD_A = O_WGU_A + SZ_WGU;
constexpr size_t O_WGU_B = O_WD_A + SZ_WD;
constexpr size_t O_WD_B = O_WGU_B + SZ_WGU;
constexpr size_t O_WIN = O_WD_B + SZ_WD;
constexpr size_t O_WOA = O_WIN + (size_t)AINP * 2048 * 2;
constexpr size_t O_WKV = O_WOA + SZ_SQ;
constexpr size_t O_WQB = O_WKV + (size_t)512 * 2048 * 2;
constexpr size_t O_WOB = O_WQB + SZ_SQ;
constexpr size_t O_H = O_WOB + SZ_SQ;
constexpr size_t O_HB = O_H + (size_t)MP * DM * 4;
constexpr size_t O_R1 = O_HB + (size_t)MP * DM * 2;
constexpr size_t O_PROJF = O_R1 + (size_t)MP * 3072 * 2;
constexpr size_t SZ_R1 = (size_t)MP * 3072 * 2 + (size_t)MP * 1280 * 4;
static_assert(SZ_R1 >= (size_t)MP * DFF * 2 && SZ_R1 >= (size_t)MP * DM * 4, "R1");
constexpr size_t O_QO = O_R1 + SZ_R1;
constexpr size_t O_KA = O_QO + (size_t)MP * DM * 2;
constexpr size_t O_VTA = O_KA + (size_t)MP * 512 * 2;
constexpr size_t O_QI = O_VTA + (size_t)NB * 4 * 128 * TP * 2;
constexpr size_t O_KI = O_QI + (size_t)MP * 1024 * 2;
constexpr size_t O_WI = O_KI + (size_t)MP * 64 * 2;
constexpr size_t O_MASK = O_WI + (size_t)MP * 16 * 4;
constexpr size_t O_KB = al256(O_MASK + (size_t)MP * MW * 4);
constexpr size_t O_VTB = O_KB + (size_t)MP * 256 * 2;
constexpr size_t O_PART = al256(O_VTB + (size_t)NB * 4 * 64 * TP * 2);
constexpr size_t O_BAR = O_PART + (size_t)15 * 128 * 2048 * 4;
constexpr size_t WS_END = O_BAR + 16384;
static_assert(WS_END <= (size_t)760 * 1000 * 1000, "workspace budget");

__device__ const float INV16[16] = {1.000000000e+00f, 4.403665960e-01f, 1.939227432e-01f, 8.539710194e-02f, 3.760603070e-02f, 1.656043902e-02f, 7.292664610e-03f, 3.211445874e-03f,
                                    1.414213562e-03f, 6.227723788e-04f, 2.742481884e-04f, 1.207697351e-04f, 5.318296098e-05f, 2.341999971e-05f, 1.031338616e-05f, 4.541670478e-06f};

struct Frame {
    LAS unsigned char* lds; int tid, lane, wave, G, c, gw, NGW, cgw, cNGW, cnt_st, cmode;
    float* out; unsigned char* ws;
    DI const float* in(int k) const { return (const float*)((const GAS float*)(*(const LAS unsigned long long*)(lds + PTRTAB_OFF + 8 * k))); }
};
DI float bf2f(bf16_t b) { return __uint_as_float((unsigned)b << 16); }
DI float wave_sum(float v) {
#pragma unroll
    for (int o = 1; o < 64; o <<= 1) v += __shfl_xor(v, o);
    return v;
}
DI void rope_cs(float tpos, float inv, float& cs, float& sn) {
    const float ang = tpos * inv; double rv = (double)ang * 0.15915494309189535; rv -= __builtin_rint(rv);
    const float fr = (float)rv; cs = __builtin_amdgcn_cosf(fr); sn = __builtin_amdgcn_sinf(fr);
}
DI int perm16(int t) { return (t & ~15) | (t & 3) | ((t & 4) << 1) | ((t & 8) >> 1); }

DI void cvt_item(const float* W, int ldw, int N, const float* gain, bf16_t* WT, int K, int mode, int item, int nblk, LAS float* scr, int lane, int nt_st) {
    const int kb = item / nblk, nb = item - kb * nblk, k0 = 64 * kb, n0 = 64 * nb;
    const int cc = n0 + (lane & 15) * 4; const bool ok = cc < N;
    f32x4 v[16]; float gv[16];
#pragma unroll
    for (int i = 0; i < 16; ++i) { const int kk = 4 * i + (lane >> 4); v[i] = (f32x4){0.f, 0.f, 0.f, 0.f}; if (ok) v[i] = __builtin_nontemporal_load((const f32x4*)(W + (size_t)(k0 + kk) * ldw + cc)); gv[i] = gain ? gain[k0 + kk] : 1.0f; }
#pragma unroll
    for (int i = 0; i < 16; ++i) { const int kk = 4 * i + (lane >> 4); LAS float* d = scr + kk * 65 + (lane & 15) * 4;
        d[0] = v[i][0] * gv[i]; d[1] = v[i][1] * gv[i]; d[2] = v[i][2] * gv[i]; d[3] = v[i][3] * gv[i]; }
    asm volatile("s_waitcnt lgkmcnt(0)" ::: "memory");
    const int rbase = (mode == 0) ? n0 : ((n0 >> 7) * 256 + (n0 & 127) + (mode == 2 ? 128 : 0));
#pragma unroll
    for (int j = 0; j < 8; ++j) { const int idx = lane + 64 * j, n = idx >> 3, ch = idx & 7; const LAS float* s = scr + (8 * ch) * 65 + n;
        u32x4 o; o.x = pk_bf16(s[0 * 65], s[1 * 65]); o.y = pk_bf16(s[2 * 65], s[3 * 65]); o.z = pk_bf16(s[4 * 65], s[5 * 65]); o.w = pk_bf16(s[6 * 65], s[7 * 65]);
        if (nt_st) __builtin_nontemporal_store(o, (u32x4*)(WT + (size_t)(rbase + n) * K + k0 + 8 * ch)); else *(u32x4*)(WT + (size_t)(rbase + n) * K + k0 + 8 * ch) = o; }
    asm volatile("s_waitcnt lgkmcnt(0)" ::: "memory");
}
DI void cvt_job(Frame& F, const float* W, int ldw, int N, int Npad, const float* gain, bf16_t* WT, int K, int mode) {
    LAS float* scr = (LAS float*)(F.lds + F.wave * 16640);
    const int nblk = Npad / 64, nitems = (K / 64) * nblk;
    for (int v = F.cgw;; v += F.cNGW) { const int it = (F.cmode == 0) ? v : (F.cmode == 1) ? ((v >> 2) * 5 + (v & 3)) : (v * 5 + 4); if (it >= nitems) break;
        cvt_item(W, ldw, N, gain, WT, K, mode, it, nblk, scr, F.lane, F.cnt_st); }
}
DI void cvt_ffn(Frame& F, const float* nrm, const float* wg, const float* wu, const float* wd, int layer, bf16_t* WGU, bf16_t* WD) {
    cvt_job(F, wg + (size_t)layer * 2048 * DFF, DFF, DFF, DFF, nrm + layer * 2048, WGU, 2048, 1);
    cvt_job(F, wu + (size_t)layer * 2048 * DFF, DFF, DFF, DFF, nrm + layer * 2048, WGU, 2048, 2);
    cvt_job(F, wd + (size_t)layer * DFF * 2048, 2048, 2048, 2048, nullptr, WD, DFF, 0);
}

DI void p_prologue(Frame& F, bool zero_bar) {
    unsigned char* ws = F.ws;
    cvt_ffn(F, F.in(2), F.in(3), F.in(4), F.in(5), 0, (bf16_t*)(ws + O_WGU_A), (bf16_t*)(ws + O_WD_A));
    cvt_job(F, F.in(11), 4176, 4176, AINP, F.in(10), (bf16_t*)(ws + O_WIN), 2048, 0);
    cvt_job(F, F.in(15), 2048, 2048, 2048, nullptr, (bf16_t*)(ws + O_WOA), 2048, 0);
    cvt_job(F, F.in(17), 512, 512, 512, F.in(16), (bf16_t*)(ws + O_WKV), 2048, 0);
    cvt_job(F, F.in(20), 2048, 2048, 2048, F.in(19), (bf16_t*)(ws + O_WQB), 2048, 0);
    cvt_job(F, F.in(23), 2048, 2048, 2048, nullptr, (bf16_t*)(ws + O_WOB), 2048, 0);
    float* ss = (float*)(ws + O_SS);
    for (int i = F.gw * 64 + F.lane; i < 7 * MP; i += F.NGW * 64) ss[MP + i] = 0.f;
    if (F.c == 0 && zero_bar) for (int i = F.tid; i < 4096; i += NWAVES * 64) ((unsigned*)(ws + O_BAR))[i] = 0u;
    bf16_t* hb = (bf16_t*)(ws + O_HB);
    const float* x = F.in(0); const float* meta = F.in(1);
    for (int m = F.gw; m < MP; m += F.NGW) {
        const int b = m / T, t = m - b * T;
        const float* src = (t < 16) ? meta + (size_t)t * DM : x + ((size_t)(b * 2048 + t - 16)) * DM;
        const bool valid = m < M; float s = 0.f;
#pragma unroll
        for (int j = 0; j < 8; ++j) {
            f32x4 v = (f32x4){0.f, 0.f, 0.f, 0.f}; if (valid) v = __builtin_nontemporal_load((const f32x4*)(src + j * 256 + F.lane * 4));
            u32x2 w; w.x = pk_bf16(v[0], v[1]); w.y = pk_bf16(v[2], v[3]); *(u32x2*)(hb + (size_t)m * DM + j * 256 + F.lane * 4) = w;
            s += (v[0] * v[0] + v[1] * v[1]) + (v[2] * v[2] + v[3] * v[3]);
        }
        s = wave_sum(s); if (F.lane == 0) ss[m] = s;
    }
}

DI void head128_norm_rope(f32x4& v, const f32x4 g4, const float (&cs)[4], const float (&sn)[4], int lane) {
    float s = (v[0] * v[0] + v[1] * v[1]) + (v[2] * v[2] + v[3] * v[3]);
    s += __shfl_xor(s, 1); s += __shfl_xor(s, 2); s += __shfl_xor(s, 4); s += __shfl_xor(s, 8); s += __shfl_xor(s, 16);
    const float rn = __builtin_amdgcn_rsqf(s * (1.0f / 128.0f) + EPS);
    const int sub = lane & 31;
#pragma unroll
    for (int c = 0; c < 4; ++c) { const float y = v[c] * rn * g4[c]; const float p = __shfl_xor(y, 4);
        v[c] = (sub < 4) ? (y * cs[c] - p * sn[c]) : ((sub < 8) ? (y * cs[c] + p * sn[c]) : y); }
}
template <bool NORM> DI void head64_norm_rope(f32x4& v, const f32x4 g4, const float (&cs)[4], const float (&sn)[4], int lane) {
    float rn = 1.0f;
    if (NORM) { float s = (v[0] * v[0] + v[1] * v[1]) + (v[2] * v[2] + v[3] * v[3]);
        s += __shfl_xor(s, 1); s += __shfl_xor(s, 2); s += __shfl_xor(s, 4); s += __shfl_xor(s, 8);
        rn = __builtin_amdgcn_rsqf(s * (1.0f / 64.0f) + EPS); }
    const int l16 = lane & 15;
#pragma unroll
    for (int c = 0; c < 4; ++c) { const float y = NORM ? v[c] * rn * g4[c] : v[c]; const float p = __shfl_xor(y, 2);
        v[c] = (l16 < 2) ? (y * cs[c] - p * sn[c]) : ((l16 < 4) ? (y * cs[c] + p * sn[c]) : y); }
}
DI void store4_bf16(bf16_t* p, const f32x4 v, float sc) { u32x2 w; w.x = pk_bf16(v[0] * sc, v[1] * sc); w.y = pk_bf16(v[2] * sc, v[3] * sc); *(u32x2*)p = w; }
DI f32x4 load4_bf16(const bf16_t* p) { const u32x2 w = *(const u32x2*)p; return (f32x4){__uint_as_float(w.x << 16), __uint_as_float(w.x & 0xffff0000u), __uint_as_float(w.y << 16), __uint_as_float(w.y & 0xffff0000u)}; }
DI void zero_vt_pad(Frame& F, bf16_t* vt, int nrows, int gw, int NGW) {
    for (int rw = gw; rw < nrows; rw += NGW) if (F.lane < 6) { unsigned z = 0u; asm volatile("" : "+v"(z)); *(u32x4*)(vt + (size_t)rw * TP + T + F.lane * 8) = (u32x4){z, z, z, z}; }
}

template <int NV, bool SRC_F32> DI void vt_transpose(Frame& F, const void* src, int ld, int col0, bf16_t* vT, int ic, int iG) {
    constexpr int NCH = NV / 8, TPG = NCH * 4, GPW = (NWAVES * 64) / TPG, NGRP = NB * (T / 16);
    const int sub = F.tid / TPG, lt = F.tid % TPG, ch = lt >> 2, q = lt & 3;
    for (int g0 = ic * GPW; g0 < NGRP; g0 += iG * GPW) {
        const int g = g0 + sub; if (g >= NGRP) continue;
        const int b = g / (T / 16), gi = g - b * (T / 16); const int t0 = gi * 16; const size_t row0 = (size_t)b * T + t0 + 4 * q;
        u32x4 v[4];
#pragma unroll
        for (int kk = 0; kk < 4; ++kk) {
            if (SRC_F32) { const float* p = (const float*)src + (row0 + kk) * ld + col0 + ch * 8; const f32x4 a = *(const f32x4*)p, c2 = *(const f32x4*)(p + 4);
                v[kk].x = pk_bf16(a[0], a[1]); v[kk].y = pk_bf16(a[2], a[3]); v[kk].z = pk_bf16(c2[0], c2[1]); v[kk].w = pk_bf16(c2[2], c2[3]); }
            else v[kk] = *(const u32x4*)((const bf16_t*)src + (row0 + kk) * ld + col0 + ch * 8);
        }
        const int pos = t0 + ((q & 1) << 3) + ((q & 2) << 1);
        bf16_t* dst = vT + ((size_t)b * NV + ch * 8) * TP + pos;
#pragma unroll
        for (int j = 0; j < 8; ++j) {
            unsigned e[4];
#pragma unroll
            for (int kk = 0; kk < 4; ++kk) e[kk] = (j & 1) ? (v[kk][j >> 1] >> 16) : (v[kk][j >> 1] & 0xffffu);
            u32x2 w; w.x = e[0] | (e[1] << 16); w.y = e[2] | (e[3] << 16);
            *(u32x2*)(dst + (size_t)j * TP) = w;
        }
    }
}

DI f32x4 unpack4(const u32x2 w) { return (f32x4){__uint_as_float(w.x << 16), __uint_as_float(w.x & 0xffff0000u), __uint_as_float(w.y << 16), __uint_as_float(w.y & 0xffff0000u)}; }
DI void p_post_a(Frame& F) {
    unsigned char* ws = F.ws; const int lane = F.lane;
    const bf16_t* projb = (const bf16_t*)(ws + O_R1); const float* projf = (const float*)(ws + O_PROJF);
    bf16_t* qo = (bf16_t*)(ws + O_QO); bf16_t* kA = (bf16_t*)(ws + O_KA); bf16_t* vT = (bf16_t*)(ws + O_VTA);
    bf16_t* qi = (bf16_t*)(ws + O_QI); bf16_t* ki = (bf16_t*)(ws + O_KI); float* wi = (float*)(ws + O_WI);
    const int sub = lane & 31, l16 = lane & 15;
    const f32x4 gq = *(const f32x4*)(F.in(12) + sub * 4), gk = *(const f32x4*)(F.in(13) + sub * 4), gi = *(const f32x4*)(F.in(14) + l16 * 4);
    float inv_a[4], inv_i[4];
#pragma unroll
    for (int c = 0; c < 4; ++c) { inv_a[c] = INV16[(sub & 3) * 4 + c]; inv_i[c] = INV16[2 * ((lane & 1) * 4 + c)]; }
    u32x2 rb[12]; f32x4 rf[5]; float rw = 0.f;
#define PA_LOAD(mm) do { const bf16_t* pb_ = projb + (size_t)(mm) * 3072; const float* pf_ = projf + (size_t)(mm) * 1280; \
        _Pragma("unroll") for (int i_ = 8; i_ < 10; ++i_) rb[i_] = *(const u32x2*)(pb_ + i_ * 256 + lane * 4); \
        rf[4] = *(const f32x4*)(pf_ + 1024 + l16 * 4); rw = pf_[1088 + l16]; } while (0)
    int m = F.gw; if (m < MP) PA_LOAD(m);
    for (; m < MP; m += F.NGW) {
        u32x2 cb[12]; f32x4 cf[5]; const float cw = rw;
#pragma unroll
        for (int i = 8; i < 10; ++i) cb[i] = rb[i];
        cf[4] = rf[4];
        if (m + F.NGW < MP) PA_LOAD(m + F.NGW);
        const int b = m / T, t = m - b * T; const bool valid = m < M; const float tp = valid ? (float)t : 0.f;
        float csa[4], sna[4], csi[4], sni[4];
#pragma unroll
        for (int c = 0; c < 4; ++c) { rope_cs(tp, inv_a[c], csa[c], sna[c]); rope_cs(tp, inv_i[c], csi[c], sni[c]); }
#pragma unroll
        for (int it = 0; it < 2; ++it) { f32x4 v = unpack4(cb[8 + it]); head128_norm_rope(v, gk, csa, sna, lane); store4_bf16(kA + (size_t)m * 512 + it * 256 + lane * 4, v, 1.0f); }
        { f32x4 v = cf[4]; head64_norm_rope<true>(v, gi, csi, sni, lane); if (lane < 16) store4_bf16(ki + (size_t)m * 64 + lane * 4, v, 1.0f); }
        if (lane < 16) wi[(size_t)m * 16 + lane] = cw * 0.03125f;
    }
#undef PA_LOAD
    vt_transpose<512, false>(F, projb, 3072, 2560, vT, F.c, F.G);
    zero_vt_pad(F, vT, NB * 4 * 128, F.gw, F.NGW);
}

DI void unpack8(const u32x4 w, float (&x)[8]) {
#pragma unroll
    for (int i = 0; i < 4; ++i) { x[2 * i] = __uint_as_float(w[i] << 16); x[2 * i + 1] = __uint_as_float(w[i] & 0xffff0000u); }
}
DI bf16x8 pack8(const float (&x)[8], float sc) { u32x4 w; w.x = pk_bf16(x[0] * sc, x[1] * sc); w.y = pk_bf16(x[2] * sc, x[3] * sc); w.z = pk_bf16(x[4] * sc, x[5] * sc); w.w = pk_bf16(x[6] * sc, x[7] * sc); return __builtin_bit_cast(bf16x8, w); }
DI void qprep128(const bf16_t* qrow, const float* gain, float tpos, int h, bf16x8 (&qf)[8]) {
    float x[8][8]; float ss = 0.f;
#pragma unroll
    for (int s = 0; s < 8; ++s) { unpack8(*(const u32x4*)(qrow + 16 * s + 8 * h), x[s]);
#pragma unroll
        for (int j = 0; j < 8; ++j) ss += x[s][j] * x[s][j]; }
    ss += __shfl_xor(ss, 32);
    const float rn = __builtin_amdgcn_rsqf(ss * (1.0f / 128.0f) + EPS);
#pragma unroll
    for (int s = 0; s < 8; ++s) { const f32x4 g0 = *(const f32x4*)(gain + 16 * s + 8 * h), g1 = *(const f32x4*)(gain + 16 * s + 8 * h + 4);
#pragma unroll
        for (int j = 0; j < 4; ++j) { x[s][j] *= rn * g0[j]; x[s][4 + j] *= rn * g1[j]; } }
#pragma unroll
    for (int j = 0; j < 8; ++j) { float cs, sn; rope_cs(tpos, INV16[8 * h + j], cs, sn); const float x1 = x[0][j], x2 = x[1][j]; x[0][j] = x1 * cs - x2 * sn; x[1][j] = x2 * cs + x1 * sn; }
#pragma unroll
    for (int s = 0; s < 8; ++s) qf[s] = pack8(x[s], QSCALE_A);
}
DI void qprep64(const bf16_t* qrow, const float* gain, float tpos, int h, bf16x8 (&qf)[4]) {
    float x[4][8]; float ss = 0.f;
#pragma unroll
    for (int s = 0; s < 4; ++s) { unpack8(*(const u32x4*)(qrow + 16 * s + 8 * h), x[s]);
#pragma unroll
        for (int j = 0; j < 8; ++j) ss += x[s][j] * x[s][j]; }
    ss += __shfl_xor(ss, 32);
    const float rn = __builtin_amdgcn_rsqf(ss * (1.0f / 64.0f) + EPS);
#pragma unroll
    for (int s = 0; s < 4; ++s) { const f32x4 g0 = *(const f32x4*)(gain + 16 * s + 8 * h), g1 = *(const f32x4*)(gain + 16 * s + 8 * h + 4);
#pragma unroll
        for (int j = 0; j < 4; ++j) { x[s][j] *= rn * g0[j]; x[s][4 + j] *= rn * g1[j]; } }
#pragma unroll
    for (int j = 0; j < 8; ++j) { float cs, sn; rope_cs(tpos, INV16[2 * j], cs, sn); const float y = x[0][j]; const float p = __shfl_xor(y, 32); x[0][j] = h ? (y * cs + p * sn) : (y * cs - p * sn); }
#pragma unroll
    for (int s = 0; s < 4; ++s) qf[s] = pack8(x[s], QSCALE_B);
}

template <int J> DI void select_mask(const LAS float* scq, int t, int lane, unsigned* mrow) {
    unsigned u[J];
#pragma unroll
    for (int j = 0; j < J; ++j) { const int key = lane + 64 * j; const unsigned bits = __float_as_uint(scq[key]);
        const unsigned uu = bits ^ ((unsigned)((int)bits >> 31) | 0x80000000u); u[j] = (key <= t) ? uu : 0u; }
    unsigned thr = 0u;
    if (t >= 256) {
        for (int bit = 31; bit >= 0; --bit) { const unsigned cand = thr | (1u << bit); int cnt = 0;
#pragma unroll
            for (int j = 0; j < J; ++j) cnt += __popcll(__ballot(u[j] >= cand));
            if (cnt >= 256) thr = cand;
            if (cnt == 256) break; }
    }
    u64 mine = 0ull;
#pragma unroll
    for (int j = 0; j < J; ++j) { const u64 bal = __ballot((u[j] >= thr) && (lane + 64 * j <= t)); if (lane == j) mine = bal; }
    if (lane < 33) ((u64*)mrow)[lane] = mine;
}

DI void p_index(Frame& F) {
    unsigned char* ws = F.ws; const int lane = F.lane, r = lane & 31, h = lane >> 5, tid = F.tid;
    const bf16_t* ki = (const bf16_t*)(ws + O_KI); const float* wi = (const float*)(ws + O_WI);
    unsigned* maskbits = (unsigned*)(ws + O_MASK);
    LAS float* sc = (LAS float*)(F.lds) + F.wave * (2 * TP);
    constexpr int KT_OFF = NWAVES * 2 * TP * 4, KTS = 144;
    static_assert(KT_OFF + 64 * KTS <= PTRTAB_OFF, "index LDS map");
    LAS unsigned char* kt_lds = F.lds + KT_OFF;
    constexpr int NGRP = T / 16, NITEMS = NB * NGRP;
    for (int i = 0;; ++i) {
        const int k = i * F.G + ((i & 1) ? (F.G - 1 - F.c) : F.c); if (k >= NITEMS) break;
        const int b = k & 7, gi = NGRP - 1 - (k >> 3); const int t0 = 16 * gi + 2 * F.wave; const size_t m0 = (size_t)b * T + t0;
        const int nkt = ((16 * gi + 15) >> 6) + 1;
        bf16x8 af[4];
        { const float* qrow = (const float*)(ws + O_PROJF) + (m0 + (r >> 4)) * 1280 + (r & 15) * 64 + 8 * h; const float tpos = (float)(t0 + (r >> 4));
#pragma unroll
          for (int s = 0; s < 4; ++s) { const f32x4 v0 = *(const f32x4*)(qrow + 16 * s), v1 = *(const f32x4*)(qrow + 16 * s + 4);
              float x[8] = {v0[0], v0[1], v0[2], v0[3], v1[0], v1[1], v1[2], v1[3]};
              if (s == 0) {
#pragma unroll
                  for (int j = 0; j < 8; ++j) { float cs, sn; rope_cs(tpos, INV16[2 * j], cs, sn); const float y = x[j]; const float p = __shfl_xor(y, 32); x[j] = h ? (y * cs + p * sn) : (y * cs - p * sn); } }
              af[s] = pack8(x, 1.0f); } }
        float w[16];
#pragma unroll
        for (int j = 0; j < 16; ++j) w[j] = wi[(m0 + (j >> 3)) * 16 + (j & 3) + 8 * ((j >> 2) & 1) + 4 * h];
        const bf16_t* kg = ki + ((size_t)b * T + (tid >> 3)) * 64 + (tid & 7) * 8;
        u32x4 kreg = *(const u32x4*)kg, kreg1 = *(const u32x4*)(kg + (size_t)((1 < nkt) ? 1 : 0) * 64 * 64), kreg2 = *(const u32x4*)(kg + (size_t)((2 < nkt) ? 2 : 0) * 64 * 64);
        for (int kt = 0; kt < nkt; ++kt) {
            __syncthreads();
            *(LAS u32x4*)(kt_lds + (tid >> 3) * KTS + (tid & 7) * 16) = kreg;
            __syncthreads();
            kreg = kreg1; kreg1 = kreg2; { const int kn = (kt + 3 < nkt) ? kt + 3 : nkt - 1; kreg2 = *(const u32x4*)(kg + (size_t)kn * 64 * 64); }
            bf16x8 bq[2][4];
#pragma unroll
            for (int kb = 0; kb < 2; ++kb)
#pragma unroll
                for (int s = 0; s < 4; ++s) bq[kb][s] = *(const LAS bf16x8*)(kt_lds + (32 * kb + r) * KTS + (16 * s + 8 * h) * 2);
            f32x16 acc[2];
#pragma unroll
            for (int kb = 0; kb < 2; ++kb)
#pragma unroll
                for (int j = 0; j < 16; ++j) acc[kb][j] = 0.f;
#pragma unroll
            for (int s = 0; s < 4; ++s)
#pragma unroll
                for (int kb = 0; kb < 2; ++kb) acc[kb] = __builtin_amdgcn_mfma_f32_32x32x16_bf16(af[s], bq[kb][s], acc[kb], 0, 0, 0);
#pragma unroll
            for (int kb = 0; kb < 2; ++kb) {
                float s0 = 0.f, s1 = 0.f;
#pragma unroll
                for (int j = 0; j < 8; ++j) { s0 += fmaxf(acc[kb][j], 0.f) * w[j]; s1 += fmaxf(acc[kb][8 + j], 0.f) * w[8 + j]; }
                const float send = h ? s0 : s1; const float recv = __shfl_xor(send, 32); const float mine = (h ? s1 : s0) + recv;
                sc[h * TP + kt * 64 + kb * 32 + r] = mine;
            }
        }
        for (int q = 0; q < 2; ++q) { const int t = t0 + q; unsigned* mrow = maskbits + (m0 + q) * MW;
            if (t < 64 * 17) select_mask<17>(sc + q * TP, t, lane, mrow); else select_mask<33>(sc + q * TP, t, lane, mrow); }
    }
}

template <int D, int KS, int VS, int NKB> DI void attn_step(const bf16x8 (&qf)[D / 16], const LAS unsigned char* Kt, const LAS unsigned char* Vt, const unsigned (&mw)[NKB], float& mrun, float& lrun, f32x16 (&o)[D / 32], int r, int h) {
    f32x16 s[NKB];
#pragma unroll
    for (int kb = 0; kb < NKB; ++kb)
#pragma unroll
        for (int j = 0; j < 16; ++j) s[kb][j] = 0.f;
    constexpr int KBATCH = 4 / NKB;
#pragma unroll
    for (int k0 = 0; k0 < D / 16; k0 += KBATCH) {
        bf16x8 a[NKB][KBATCH];
#pragma unroll
        for (int kb = 0; kb < NKB; ++kb)
#pragma unroll
            for (int kk = 0; kk < KBATCH; ++kk) a[kb][kk] = *(const LAS bf16x8*)(Kt + (32 * kb + r) * KS + (16 * (k0 + kk) + 8 * h) * 2);
        asm volatile("" ::: "memory");
#pragma unroll
        for (int kk = 0; kk < KBATCH; ++kk)
#pragma unroll
            for (int kb = 0; kb < NKB; ++kb) s[kb] = __builtin_amdgcn_mfma_f32_32x32x16_bf16(a[kb][kk], qf[k0 + kk], s[kb], 0, 0, 0);
    }
    float mx = -INFINITY;
#pragma unroll
    for (int kb = 0; kb < NKB; ++kb) { const unsigned mh = mw[kb] >> (4 * h);
#pragma unroll
        for (int j = 0; j < 16; ++j) { const int t = __builtin_amdgcn_sbfe((int)mh, (j & 3) + 8 * (j >> 2), 1);
            const unsigned sb = (__float_as_uint(s[kb][j]) & (unsigned)t) | (~(unsigned)t & 0xff800000u); s[kb][j] = __uint_as_float(sb); mx = fmaxf(mx, s[kb][j]); } }
    mx = fmaxf(mx, __shfl_xor(mx, 32));
    if (__any(mx > mrun + 8.0f)) {
        const float mnew = fmaxf(mrun, mx); const float ms = (mnew == -INFINITY) ? 0.f : mnew;
        const float alpha = __builtin_amdgcn_exp2f(mrun - ms); mrun = mnew; lrun *= alpha;
#pragma unroll
        for (int db = 0; db < D / 32; ++db)
#pragma unroll
            for (int j = 0; j < 16; ++j) o[db][j] *= alpha;
    }
    const float msafe = (mrun == -INFINITY) ? 0.f : mrun;
    float ls = 0.f;
#pragma unroll
    for (int kb = 0; kb < NKB; ++kb)
#pragma unroll
        for (int j = 0; j < 16; ++j) { s[kb][j] = __builtin_amdgcn_exp2f(s[kb][j] - msafe); ls += s[kb][j]; }
    lrun += ls;
#pragma unroll
    for (int kb = 0; kb < NKB; ++kb) {
#pragma unroll
        for (int s2 = 0; s2 < 2; ++s2) {
            bf16x8 va[D / 32];
#pragma unroll
            for (int db = 0; db < D / 32; ++db) va[db] = *(const LAS bf16x8*)(Vt + (32 * db + r) * VS + (32 * kb + 16 * s2 + 8 * h) * 2);
            asm volatile("" ::: "memory");
            u32x4 pw; pw.x = pk_bf16(s[kb][8 * s2 + 0], s[kb][8 * s2 + 1]); pw.y = pk_bf16(s[kb][8 * s2 + 2], s[kb][8 * s2 + 3]); pw.z = pk_bf16(s[kb][8 * s2 + 4], s[kb][8 * s2 + 5]); pw.w = pk_bf16(s[kb][8 * s2 + 6], s[kb][8 * s2 + 7]);
            const bf16x8 pb = __builtin_bit_cast(bf16x8, pw);
#pragma unroll
            for (int db = 0; db < D / 32; ++db) o[db] = __builtin_amdgcn_mfma_f32_32x32x16_bf16(va[db], pb, o[db], 0, 0, 0);
        }
    }
}
template <int D, int SS> DI void attn_store(const f32x16 (&o)[D / 32], float inv, LAS unsigned char* stg, bf16_t* dst  , int nvalid, int lane_in) {
    int lane = lane_in; asm volatile("" : "+v"(lane));
    const int r = lane & 31, h = lane >> 5;
#pragma unroll
    for (int db = 0; db < D / 32; ++db)
#pragma unroll
        for (int g4 = 0; g4 < 4; ++g4) { u32x2 w; w.x = pk_bf16(o[db][4 * g4] * inv, o[db][4 * g4 + 1] * inv); w.y = pk_bf16(o[db][4 * g4 + 2] * inv, o[db][4 * g4 + 3] * inv);
            *(LAS u32x2*)(stg + r * SS + (32 * db + 8 * g4 + 4 * h) * 2) = w; }
    asm volatile("s_waitcnt lgkmcnt(0)" ::: "memory");
    constexpr int CPR = D / 8;
#pragma unroll
    for (int j = 0; j < (32 * CPR) / 64; ++j) { const int idx = lane + 64 * j, row = idx / CPR, ch = idx % CPR;
        const u32x4 v = *(const LAS u32x4*)(stg + row * SS + ch * 16); if (row < nvalid) *(u32x4*)(dst + (size_t)row * DM + ch * 8) = v; }
    asm volatile("s_waitcnt lgkmcnt(0)" ::: "memory");
}

DI void p_attn_a(Frame& F) {
    unsigned char* ws = F.ws; const int tid = F.tid, lane = F.lane, r = lane & 31, h = lane >> 5, w = F.wave, g = w & 3, qh = w >> 2;
    bf16_t* qo = (bf16_t*)(ws + O_QO); const bf16_t* kA = (const bf16_t*)(ws + O_KA); const bf16_t* vT = (const bf16_t*)(ws + O_VTA);
    const unsigned* maskbits = (const unsigned*)(ws + O_MASK);
    constexpr int KS = 272, VS = 144, KBYTES = 64 * KS, VBYTES = 128 * VS;
    LAS unsigned char* L = F.lds;
    constexpr int NUNITS = NB * 4 * 33;
    for (int i = 0;; ++i) {
        const int u = i * F.G + ((i & 1) ? (F.G - 1 - F.c) : F.c); if (u >= NUNITS) break;
        int tidl = tid; asm volatile("" : "+v"(tidl));
        const int qb = 32 - (u >> 5), bk = u & 31, b = bk >> 2, kvh = bk & 3;
        const int tq = qb * 64 + qh * 32 + r; const int tqc = tq < T ? tq : T - 1; const size_t mq = (size_t)b * T + tqc;
        bf16x8 qf[8];
        { int hh = h; asm volatile("" : "+v"(hh)); qprep128((const bf16_t*)(ws + O_R1) + mq * 3072 + (kvh * 4 + g) * 128, F.in(12), (float)tqc, hh, qf); }
        float mrun = -INFINITY, lrun = 0.f; f32x16 o[4];
#pragma unroll
        for (int db = 0; db < 4; ++db)
#pragma unroll
            for (int j = 0; j < 16; ++j) o[db][j] = 0.f;
        const int NT = qb + 1;
        const bf16_t* kg = kA + ((size_t)b * T) * 512 + kvh * 128; const bf16_t* vg = vT + ((size_t)(b * 4 + kvh) * 128) * TP;
        u32x4 kst[2], vst[2];
#define LOADT(kt) do { _Pragma("unroll") for (int p = 0; p < 2; ++p) { const int idx = tidl + 512 * p; \
            kst[p] = *(const u32x4*)(kg + ((size_t)(kt) * 64 + (idx >> 4)) * 512 + (idx & 15) * 8); \
            vst[p] = *(const u32x4*)(vg + (size_t)(idx >> 3) * TP + (kt) * 64 + (idx & 7) * 8); } } while (0)
#define WRITET(buf) do { _Pragma("unroll") for (int p = 0; p < 2; ++p) { const int idx = tidl + 512 * p; \
            *(LAS u32x4*)(L + (buf) * KBYTES + (idx >> 4) * KS + (idx & 15) * 16) = kst[p]; \
            *(LAS u32x4*)(L + 2 * KBYTES + (buf) * VBYTES + (idx >> 3) * VS + (idx & 7) * 16) = vst[p]; } } while (0)
        LOADT(0); u32x2 mk = *(const u32x2*)(maskbits + mq * MW);
        WRITET(0); __syncthreads();
        for (int kt = 0; kt < NT; ++kt) {
            u32x2 mkn = mk;
            if (kt + 1 < NT) { LOADT(kt + 1); mkn = *(const u32x2*)(maskbits + mq * MW + 2 * (kt + 1)); }
            const int buf = kt & 1;
            const LAS unsigned char* Kt = L + buf * KBYTES; const LAS unsigned char* Vt = L + 2 * KBYTES + buf * VBYTES;
            { const unsigned mw2[2] = {mk.x, mk.y}; attn_step<128, KS, VS, 2>(qf, Kt, Vt, mw2, mrun, lrun, o, r, h); }
            if (kt + 1 < NT) WRITET(buf ^ 1);
            __syncthreads();
            mk = mkn;
        }
#undef LOADT
#undef WRITET
        const float lt = lrun + __shfl_xor(lrun, 32); const float inv = 1.0f / lt;
        const int t0w = qb * 64 + qh * 32; const int nvalid = (T - t0w) < 32 ? (T - t0w) : 32;
        attn_store<128, 272>(o, inv, L + w * (32 * 272), qo + ((size_t)b * T + t0w) * DM + (kvh * 4 + g) * 128, nvalid, lane);
        __syncthreads();
    }
}

DI void p_post_kv(Frame& F) {
    unsigned char* ws = F.ws; const int lane = F.lane, l16 = lane & 15;
    const float* kvraw = (const float*)(ws + O_R1); bf16_t* kB = (bf16_t*)(ws + O_KB); bf16_t* vT = (bf16_t*)(ws + O_VTB);
    const int gw_ = F.cgw, NGW_ = F.cNGW;
    const f32x4 gk = *(const f32x4*)(F.in(18) + l16 * 4);
    float inv_i[4];
#pragma unroll
    for (int c = 0; c < 4; ++c) inv_i[c] = INV16[2 * ((lane & 1) * 4 + c)];
    f32x4 rk;
    int m = gw_; if (m < MP) rk = *(const f32x4*)(kvraw + (size_t)m * 512 + lane * 4);
    for (; m < MP; m += NGW_) {
        f32x4 v = rk;
        if (m + NGW_ < MP) rk = *(const f32x4*)(kvraw + (size_t)(m + NGW_) * 512 + lane * 4);
        const int b = m / T, t = m - b * T; const bool valid = m < M; const float tp = valid ? (float)t : 0.f;
        float csi[4], sni[4];
#pragma unroll
        for (int c = 0; c < 4; ++c) rope_cs(tp, inv_i[c], csi[c], sni[c]);
        head64_norm_rope<true>(v, gk, csi, sni, lane); store4_bf16(kB + (size_t)m * 256 + lane * 4, v, 1.0f);
    }
    vt_transpose<256, true>(F, kvraw, 512, 256, vT, gw_ / NWAVES, NGW_ / NWAVES);
    zero_vt_pad(F, vT, NB * 4 * 64, gw_, NGW_);
}
DI void p_post_qb(Frame& F) {
    unsigned char* ws = F.ws; const int lane = F.lane, l16 = lane & 15;
    const bf16_t* qraw = (const bf16_t*)(ws + O_R1); bf16_t* qo = (bf16_t*)(ws + O_QO);
    const f32x4 gq = *(const f32x4*)(F.in(21) + l16 * 4);
    float inv_i[4];
#pragma unroll
    for (int c = 0; c < 4; ++c) inv_i[c] = INV16[2 * ((lane & 1) * 4 + c)];
    u32x2 rq[8];
    int m = F.gw;
    if (m < MP) {
#pragma unroll
        for (int i = 0; i < 8; ++i) rq[i] = *(const u32x2*)(qraw + (size_t)m * DM + i * 256 + lane * 4); }
    for (; m < MP; m += F.NGW) {
        u32x2 cq[8];
#pragma unroll
        for (int i = 0; i < 8; ++i) cq[i] = rq[i];
        if (m + F.NGW < MP) {
#pragma unroll
            for (int i = 0; i < 8; ++i) rq[i] = *(const u32x2*)(qraw + (size_t)(m + F.NGW) * DM + i * 256 + lane * 4); }
        const int b = m / T, t = m - b * T; const bool valid = m < M; const float tp = valid ? (float)t : 0.f;
        float csi[4], sni[4];
#pragma unroll
        for (int c = 0; c < 4; ++c) rope_cs(tp, inv_i[c], csi[c], sni[c]);
#pragma unroll
        for (int it = 0; it < 8; ++it) { f32x4 v = unpack4(cq[it]); head64_norm_rope<true>(v, gq, csi, sni, lane); store4_bf16(qo + (size_t)m * DM + it * 256 + lane * 4, v, QSCALE_B); }
    }
}

DI void p_attn_b(Frame& F) {
    unsigned char* ws = F.ws; const int tid = F.tid, lane = F.lane, r = lane & 31, h = lane >> 5, w = F.wave;
    bf16_t* qo = (bf16_t*)(ws + O_QO); const bf16_t* kB = (const bf16_t*)(ws + O_KB); const bf16_t* vT = (const bf16_t*)(ws + O_VTB);
    const bf16_t* qraw = (const bf16_t*)(ws + O_R1);
    constexpr int KS = 144, VS = 336, KBYTES = 160 * KS, VBYTES = 64 * VS, SS = 144;
    LAS unsigned char* L = F.lds; LAS unsigned char* stg = L + KBYTES + VBYTES + w * (32 * SS);
    constexpr int NUNITS = NB * 4 * 65;
    u32x4 kst[3], vst[3], qst[4];
#define AB_LOAD(u_) do { const int qb_ = (u_) >> 5, bk_ = (u_) & 31, b_ = bk_ >> 2, kvh_ = bk_ & 3; const int kb0_ = qb_ >= 4 ? qb_ - 4 : 0; \
        const bf16_t* kg_ = kB + ((size_t)b_ * T + kb0_ * 32) * 256 + kvh_ * 64; const bf16_t* vg_ = vT + ((size_t)(b_ * 4 + kvh_) * 64) * TP + kb0_ * 32; \
        _Pragma("unroll") for (int p = 0; p < 3; ++p) { const int idx = tid + 512 * p; if (idx < 1280) { const int d_ = idx / 20, chn_ = idx - d_ * 20; \
            kst[p] = *(const u32x4*)(kg_ + (size_t)(idx >> 3) * 256 + (idx & 7) * 8); vst[p] = *(const u32x4*)(vg_ + (size_t)d_ * TP + chn_ * 8); } } \
        const int tq_ = qb_ * 32 + r; const int tqc_ = tq_ < T ? tq_ : T - 1; const bf16_t* qrow_ = qraw + ((size_t)b_ * T + tqc_) * DM + (kvh_ * 8 + w) * 64 + 8 * h; \
        _Pragma("unroll") for (int s_ = 0; s_ < 4; ++s_) qst[s_] = *(const u32x4*)(qrow_ + 16 * s_); } while (0)
    if (F.c < NUNITS) AB_LOAD(F.c);
    for (int i = 0;; ++i) {
        const int u = i * F.G + F.c; if (u >= NUNITS) break;
        const int qb = u >> 5, bk = u & 31, b = bk >> 2, kvh = bk & 3, head = kvh * 8 + w;
        const int kb0 = qb >= 4 ? qb - 4 : 0, nblk = qb - kb0 + 1;
#pragma unroll
        for (int p = 0; p < 3; ++p) { const int idx = tid + 512 * p; if (idx < 1280) { const int d = idx / 20, chn = idx - d * 20;
            *(LAS u32x4*)(L + (idx >> 3) * KS + (idx & 7) * 16) = kst[p]; *(LAS u32x4*)(L + KBYTES + d * VS + chn * 16) = vst[p]; } }
        const int tq = qb * 32 + r; const int tqc = tq < T ? tq : T - 1;
        bf16x8 qf[4];
        {
            int hh = h; asm volatile("" : "+v"(hh));
            float x[4][8]; float ss = 0.f;
#pragma unroll
            for (int s = 0; s < 4; ++s) { unpack8(qst[s], x[s]);
#pragma unroll
                for (int j = 0; j < 8; ++j) ss += x[s][j] * x[s][j]; }
            ss += __shfl_xor(ss, 32);
            const float rn = __builtin_amdgcn_rsqf(ss * (1.0f / 64.0f) + EPS); const float* gain = F.in(21);
#pragma unroll
            for (int s = 0; s < 4; ++s) { const f32x4 g0 = *(const f32x4*)(gain + 16 * s + 8 * hh), g1 = *(const f32x4*)(gain + 16 * s + 8 * hh + 4);
#pragma unroll
                for (int j = 0; j < 4; ++j) { x[s][j] *= rn * g0[j]; x[s][4 + j] *= rn * g1[j]; } }
#pragma unroll
            for (int j = 0; j < 8; ++j) { float cs, sn; rope_cs((float)tqc, INV16[2 * j], cs, sn); const float y = x[0][j]; const float p = __shfl_xor(y, 32); x[0][j] = hh ? (y * cs + p * sn) : (y * cs - p * sn); }
#pragma unroll
            for (int s = 0; s < 4; ++s) qf[s] = pack8(x[s], QSCALE_B);
        }
        float mrun = -INFINITY, lrun = 0.f; f32x16 o[2];
#pragma unroll
        for (int db = 0; db < 2; ++db)
#pragma unroll
            for (int j = 0; j < 16; ++j) o[db][j] = 0.f;
        __syncthreads();
        { const int un = u + F.G; if (un < NUNITS) AB_LOAD(un); }
        for (int j = 0; j < nblk; ++j) {
            const int hi = tqc - 32 * (kb0 + j), lo = hi - 127;
            const unsigned mhi = hi >= 31 ? 0xFFFFFFFFu : (hi < 0 ? 0u : ((2u << hi) - 1u));
            const unsigned mlo = lo <= 0 ? 0xFFFFFFFFu : (lo > 31 ? 0u : (0xFFFFFFFFu << lo));
            { const unsigned mw1[1] = {mhi & mlo}; attn_step<64, KS, VS, 1>(qf, L + (32 * j) * KS, L + KBYTES + 64 * j, mw1, mrun, lrun, o, r, h); }
        }
        const float sink2 = F.in(22)[head] * LOG2E;
        const float lt = lrun + __shfl_xor(lrun, 32); const float mf = fmaxf(mrun, sink2);
        const float e0 = __builtin_amdgcn_exp2f(mrun - mf); const float den = lt * e0 + __builtin_amdgcn_exp2f(sink2 - mf); const float inv = e0 / den;
        const int t0w = qb * 32; const int nvalid = (T - t0w) < 32 ? (T - t0w) : 32;
        attn_store<64, SS>(o, inv, stg, qo + ((size_t)b * T + t0w) * DM + head * 64, nvalid, lane);
        __syncthreads();
    }
#undef AB_LOAD
}

DI void p_tail_finalize(Frame& F, const float* part, int nch, float alpha, float* ss_out, bool fin) {
    unsigned char* ws = F.ws; bf16_t* hb = (bf16_t*)(ws + O_HB);
    typedef float f32x2 __attribute__((ext_vector_type(2)));
    for (int it = F.gw; it < 128 * 16; it += F.NGW) {
        const int r = it >> 4, seg = it & 15; const int row = 16384 + r; const size_t off = (size_t)row * DM + seg * 128 + F.lane * 2;
        f32x2 s = (f32x2){0.f, 0.f};
        for (int cix = 0; cix < nch; ++cix) s += *(const f32x2*)(part + ((size_t)cix * 128 + r) * DM + seg * 128 + F.lane * 2);
        const unsigned hw = *(const unsigned*)(hb + off);
        const f32x2 v = (f32x2){__uint_as_float(hw << 16), __uint_as_float(hw & 0xffff0000u)} + s * alpha;
        if (fin) { const int b = row / T, t = row - b * T; *(f32x2*)(F.out + ((size_t)(b * 2048 + t - 16)) * DM + seg * 128 + F.lane * 2) = v; }
        else { *(unsigned*)(hb + off) = pk_bf16(v[0], v[1]);
            const float sq = wave_sum(v[0] * v[0] + v[1] * v[1]); if (F.lane == 0) atomicAdd(ss_out + row, sq); }
    }
}

typedef __attribute__((address_space(1))) unsigned gu32;
#define XB_TMO      128
#define XB_XCNT(j)  (256  + 64 * (j))
#define XB_XSUB(j)  (1280 + 64 * (j))
#define XB_XGEN(j)  (2304 + 64 * (j))
#define XB_TOP      3328
#define XB_TOPGEN   3392
#define XCD_BAR_WORDS 3456
#define XB_SPIN_CAP (1u << 18)

__device__ __forceinline__ unsigned xb_ld(unsigned* p)              { return __hip_atomic_load(p, __ATOMIC_RELAXED, __HIP_MEMORY_SCOPE_AGENT); }
__device__ __forceinline__ unsigned xb_add(unsigned* p, unsigned v) { return __hip_atomic_fetch_add(p, v, __ATOMIC_RELAXED, __HIP_MEMORY_SCOPE_AGENT); }
__device__ __forceinline__ unsigned xb_xcc_id() { return (unsigned)__builtin_amdgcn_s_getreg((3 << 11) | 20) & 0xFu; }
#define XB_SPIN(cond, bar) do { unsigned _sp = 0; while (cond) { __builtin_amdgcn_s_sleep(1); \
    if ((++_sp & 255u) == 0u) { if (xb_ld(&(bar)[XB_TMO])) break; if (_sp > XB_SPIN_CAP) { atomicAdd(&(bar)[XB_TMO], 1u); break; } } } } while (0)

struct XcdBarrier {
    unsigned* bar; unsigned x;
    volatile LAS unsigned* st;
};

__device__ __forceinline__ XcdBarrier xcd_barrier_post(unsigned* bar, volatile LAS unsigned* st) {
    XcdBarrier b; b.bar = bar; b.x = xb_xcc_id(); b.st = st;
    if (threadIdx.x == 0) (void)xb_add(&bar[XB_XCNT(b.x)], 1u);
    return b;
}
__device__ __forceinline__ void xcd_barrier_complete(unsigned* bar, unsigned x, unsigned& nloc, unsigned& nx) {
    const unsigned G = gridDim.x * gridDim.y * gridDim.z;
    unsigned sum, cnt, mine, sp = 0u;
    for (;;) {
        sum = 0u; cnt = 0u; mine = 0u;
#pragma unroll
        for (unsigned j = 0; j < 16; ++j) { const unsigned c = xb_ld(&bar[XB_XCNT(j)]); sum += c; cnt += (c > 0u) ? 1u : 0u; mine = (j == x) ? c : mine; }
        if (sum == G) break;
        __builtin_amdgcn_s_sleep(1);
        if ((++sp & 255u) == 0u) { if (xb_ld(&bar[XB_TMO])) break; if (sp > XB_SPIN_CAP) { atomicAdd(&bar[XB_TMO], 1u); break; } }
    }
    nloc = mine > 0u ? mine : 1u; nx = cnt > 0u ? cnt : 1u;
}

__device__ __forceinline__ void xcd_barrier(const XcdBarrier& b) {
    asm volatile("s_waitcnt vmcnt(0)" ::: "memory");
    __syncthreads();
    if (threadIdx.x == 0) {
        unsigned* bar = b.bar;
        __builtin_amdgcn_s_waitcnt(0);
        unsigned nloc = b.st[0], nx = b.st[1];
        if (nloc == 0u) { xcd_barrier_complete(bar, b.x, nloc, nx); b.st[0] = nloc; b.st[1] = nx; }
        const unsigned old = xb_add(&bar[XB_XSUB(b.x)], 1u);
        const unsigned gen = old / nloc;
        if (old + 1u == (gen + 1u) * nloc) {
            __builtin_amdgcn_fence(__ATOMIC_RELEASE, "agent");
            asm volatile("s_waitcnt vmcnt(0)" ::: "memory");
            const unsigned og = xb_add(&bar[XB_TOP], 1u);
            const unsigned tg = og / nx;
            if (og + 1u == (tg + 1u) * nx) xb_add(&bar[XB_TOPGEN], 1u);
            else XB_SPIN(xb_ld(&bar[XB_TOPGEN]) == tg, bar);
            __builtin_amdgcn_fence(__ATOMIC_ACQUIRE, "agent");
            xb_add(&bar[XB_XGEN(b.x)], 1u);
            asm volatile("s_waitcnt vmcnt(0)" ::: "memory");
        } else {
            XB_SPIN(xb_ld(&bar[XB_XGEN(b.x)]) == gen, bar);
            __builtin_amdgcn_fence(__ATOMIC_ACQUIRE, "agent");
            asm volatile("s_waitcnt vmcnt(0)" ::: "memory");
        }
    }
    __syncthreads();
}

struct Args { const float* in[24]; float* out; unsigned char* ws; };
__global__ void __launch_bounds__(NWAVES * 64, 2) yoco_fwd(Args args) {
    extern __shared__ __attribute__((aligned(16))) unsigned char lds_raw[];
    cg::grid_group grid = cg::this_grid();
    if (threadIdx.x == 0) {
#pragma unroll
        for (int i = 0; i < 24; ++i) *(LAS unsigned long long*)((LAS unsigned char*)lds_raw + PTRTAB_OFF + 8 * i) = (unsigned long long)args.in[i];
    }
    if (threadIdx.x == 0) { *(LAS unsigned*)((LAS unsigned char*)lds_raw + PTRTAB_OFF + 192) = 0u; *(LAS unsigned*)((LAS unsigned char*)lds_raw + PTRTAB_OFF + 196) = 0u; }
    __syncthreads();
#ifndef DUP_MASK
#define DUP_MASK 0
#endif
    for (int step2 = 0; step2 < (DUP_MASK ? 40 : 20); ++step2) {
        const int step = DUP_MASK ? (step2 >> 1) : step2;
        size_t zoff = 0; asm volatile("" : "+s"(zoff));
        unsigned char* ws = (unsigned char*)((GAS unsigned char*)args.ws + zoff);
        int tid_ = threadIdx.x; asm volatile("" : "+v"(tid_));
#define GRID_BAR() do { XcdBarrier xb_; xb_.bar = (unsigned*)(ws + O_BAR); xb_.x = xb_xcc_id(); xb_.st = (volatile LAS unsigned*)((LAS unsigned char*)lds_raw + PTRTAB_OFF + 192); xcd_barrier(xb_); } while (0)
        Frame F;
        F.lds = (LAS unsigned char*)lds_raw; F.tid = tid_; F.lane = F.tid & 63; F.wave = __builtin_amdgcn_readfirstlane(F.tid >> 6);
        int G_ = gridDim.x, c_ = blockIdx.x; asm volatile("" : "+s"(G_), "+s"(c_));
        F.G = G_; F.c = c_; F.gw = F.c * NWAVES + F.wave; F.NGW = F.G * NWAVES; F.cgw = F.gw; F.cNGW = F.NGW; F.cnt_st = 0; F.cmode = 0;
        F.out = (float*)((GAS float*)args.out + zoff); F.ws = ws;
        float* ssb = (float*)(ws + O_SS); float* h = (float*)(ws + O_H); bf16_t* hb = (bf16_t*)(ws + O_HB); bf16_t* act = (bf16_t*)(ws + O_R1); bf16_t* qo = (bf16_t*)(ws + O_QO);
        bf16_t* WGUA = (bf16_t*)(ws + O_WGU_A); bf16_t* WDA = (bf16_t*)(ws + O_WD_A); bf16_t* WGUB = (bf16_t*)(ws + O_WGU_B); bf16_t* WDB = (bf16_t*)(ws + O_WD_B);
        int kind; const bf16_t* A = hb; const bf16_t* Bt = WGUA; int N = 2048, K = 2048; int ssi = 0, sso = 0; float alpha = 0.5f; bool fin = false;
        bf16_t* pb = nullptr; int ldb = 0, nbf = 0; float* pf = nullptr; int ldf = 0;
        switch (step) {
            case 0: kind = 0; break;
            case 1: kind = 1; Bt = WGUA; ssi = 0; break;
            case 2: kind = 2; A = act; Bt = WDA; K = DFF; sso = 1; break;
            case 3: kind = 3; Bt = (const bf16_t*)(ws + O_WIN); N = AINP; ssi = 1; pb = (bf16_t*)(ws + O_R1); ldb = 3072; nbf = 12; pf = (float*)(ws + O_PROJF); ldf = 1280; break;
            case 4: kind = 4; break;
            case 5: kind = 5; break;
            case 6: kind = 6; break;
            case 7: kind = 2; A = qo; Bt = (const bf16_t*)(ws + O_WOA); sso = 2; alpha = 1.0f; break;
            case 8: kind = 1; Bt = WGUB; ssi = 2; break;
            case 9: kind = 2; A = act; Bt = WDB; K = DFF; sso = 3; break;
            case 10: kind = 3; Bt = (const bf16_t*)(ws + O_WKV); N = 512; ssi = 3; pf = (float*)(ws + O_R1); ldf = 512; break;
            case 11: kind = 7; break;
            case 12: kind = 1; Bt = WGUA; ssi = 3; break;
            case 13: kind = 2; A = act; Bt = WDA; K = DFF; sso = 4; break;
            case 14: kind = 3; Bt = (const bf16_t*)(ws + O_WQB); N = 2048; ssi = 4; pb = (bf16_t*)(ws + O_R1); ldb = 2048; nbf = 8; break;
            case 15: kind = 11; break;
            case 16: kind = 9; break;
            case 17: kind = 2; A = qo; Bt = (const bf16_t*)(ws + O_WOB); sso = 5; alpha = 1.0f; break;
            case 18: kind = 1; Bt = WGUB; ssi = 5; break;
            default: kind = 2; A = act; Bt = WDB; K = DFF; sso = 6; fin = true; break;
        }
        if (DUP_MASK && (step2 & 1) && !((DUP_MASK >> kind) & 1)) continue;
        if (kind == 11) continue;
        if (kind == 0) p_prologue(F, step2 == 0);
        else if (kind == 1) { pg8::Gemm g{A, Bt, MP, 2 * DFF, 2048}; pg8::StaticOrder S; S.init(MP, 2 * DFF, F.G, F.c, 2048);
            pg8::EpiSwiglu E{act, ssb + (size_t)ssi * MP, (DUP_MASK && ((DUP_MASK >> 1) & 1) && !(step2 & 1)) ? 1ll : 0ll}; pg8::gemm_phase<pg8::EpiSwiglu, pg8::StaticOrder, true, true>(F.lds, g, S, E); }
        else if (kind == 2) { pg8::Gemm g{A, Bt, MP, 2048, K}; pg8::ResidOrder S; S.init(K, F.G, F.c);
            if (DUP_MASK && ((DUP_MASK >> 2) & 1) && !(step2 & 1)) { alpha = 0.f; sso = 7; fin = false; }
            float* part = (float*)(ws + O_H);
            pg8::EpiResid E{hb, ssb + (size_t)sso * MP, fin ? F.out : nullptr, part, alpha, S.ch}; pg8::gemm_phase<pg8::EpiResid, pg8::ResidOrder, true, true>(F.lds, g, S, E);
            GRID_BAR();
            p_tail_finalize(F, part, S.nch, alpha, ssb + (size_t)sso * MP, fin); }
        else if (kind == 3) { pg8::Gemm g{A, Bt, MP, N, 2048}; pg8::StaticOrder S; S.init(MP, N, F.G, F.c, 2048);
            pg8::EpiScale E{pb, pf, ssb + (size_t)ssi * MP, ldb, nbf, ldf, 0}; pg8::gemm_phase<pg8::EpiScale, pg8::StaticOrder, true, true>(F.lds, g, S, E);
            const int nwg = S.nwg, r0 = nwg - ((nwg - 1) / F.G) * F.G;
            if (step == 10 && !(DUP_MASK && (step2 & 1))) {
                if (F.c >= r0) { F.cmode = 1; F.cgw = (F.c - r0) * NWAVES + F.wave; F.cNGW = (F.G - r0) * NWAVES; }
                else { F.cmode = 2; F.cgw = F.c * NWAVES + F.wave; F.cNGW = r0 * NWAVES; }
                cvt_ffn(F, F.in(2), F.in(3), F.in(4), F.in(5), 1, WGUA, WDA);
            } else if (F.c >= r0 && !(DUP_MASK && (step2 & 1))) { F.cgw = (F.c - r0) * NWAVES + F.wave; F.cNGW = (F.G - r0) * NWAVES; F.cnt_st = 0;
                if (step == 3) cvt_ffn(F, F.in(6), F.in(7), F.in(8), F.in(9), 0, WGUB, WDB);
                else cvt_ffn(F, F.in(6), F.in(7), F.in(8), F.in(9), 1, WGUB, WDB); } }
        else if (kind == 4) p_post_a(F);
        else if (kind == 7) p_post_kv(F);
        else if (kind == 5) p_index(F);
        else if (kind == 6) p_attn_a(F);
        else if (kind == 8) p_post_qb(F);
        else p_attn_b(F);
        if (step2 == 0) { grid.sync(); (void)xcd_barrier_post((unsigned*)(ws + O_BAR), (volatile LAS unsigned*)((LAS unsigned char*)lds_raw + PTRTAB_OFF + 192)); }
        else if (step2 < (DUP_MASK ? 39 : 19)) GRID_BAR();
#ifdef EXTRA_SYNCS
        if (step2 == 0) for (int es = 0; es < EXTRA_SYNCS; ++es) GRID_BAR();
#endif
    }
}

extern "C" void kernel_launch(void* const* d_in, const int* in_sizes, int n_in, void* d_out, int out_size, void* d_ws, size_t ws_size, hipStream_t stream) {
    static int grid = 0;
    if (grid == 0) {
        if (n_in != 24 || ws_size < WS_END) { fprintf(stderr, "kernel_launch: expected 24 inputs and >= %zu bytes of workspace, got %d / %zu\n", (size_t)WS_END, n_in, ws_size); grid = -1; return; }
        int dev = 0, cus = 0, per_cu = 0;
        (void)hipGetDevice(&dev); (void)hipDeviceGetAttribute(&cus, hipDeviceAttributeMultiprocessorCount, dev);
        (void)hipFuncSetAttribute((const void*)yoco_fwd, hipFuncAttributeMaxDynamicSharedMemorySize, LDS_BYTES);
        if (hipOccupancyMaxActiveBlocksPerMultiprocessor(&per_cu, (const void*)yoco_fwd, NWAVES * 64, LDS_BYTES) != hipSuccess || per_cu < 1) per_cu = 1;
        (void)hipGetLastError();
        grid = cus * per_cu;
    }
    if (grid < 0) return;
    Args a{};
    for (int i = 0; i < 24; ++i) a.in[i] = (const float*)d_in[i];
    a.out = (float*)d_out; a.ws = (unsigned char*)d_ws;
    void* kargs[] = {&a};
    hipError_t e = hipLaunchCooperativeKernel((const void*)yoco_fwd, dim3(grid), dim3(NWAVES * 64), kargs, LDS_BYTES, stream);
    if (e != hipSuccess) fprintf(stderr, "cooperative launch failed: %s (grid %d)\n", hipGetErrorString(e), grid);
}
```

```cpp
#include <hip/hip_runtime.h>
#include <hip/hip_cooperative_groups.h>
#include <cstdio>
#include <cstdint>
#include <cmath>
namespace cg = cooperative_groups;
namespace pg8 {
#define PG8_LAS __attribute__((address_space(3)))
typedef unsigned short bf16_t;
typedef short bf16x8 __attribute__((ext_vector_type(8)));
typedef float f32x4 __attribute__((ext_vector_type(4)));
typedef unsigned u32x4 __attribute__((ext_vector_type(4)));
constexpr int BM = 256, BK = 64, HALF = 128, HTB = HALF * BK * 2  , STAGE_BYTES = 8 * HTB, NXCD = 8, WGM = 8;

__host__ __device__ __forceinline__ int lds_byte(int r, int c) { const int st = (r >> 4) * 2 + (c >> 5), rr = r & 15, cc = c & 31, ob = rr * 64 + cc * 2; return st * 1024 + (ob ^ (((ob >> 9) & 1) << 5)); }
__host__ __device__ __forceinline__ void stage_rc(int b, int& R, int& C) { const int st = b / 1024, sb = b % 1024, swz = sb ^ (((sb >> 9) & 1) << 5); R = (st >> 1) * 16 + swz / 64; C = (st & 1) * 32 + (swz % 64) / 2; }
__host__ __device__ __forceinline__ int perm32(int rho) { const int n = rho >> 4, i = rho & 15; return 8 * (i >> 2) + 4 * n + (i & 3); }

struct Unit { int pm, pn, k0, nt; };
struct Gemm { const bf16_t* A; const bf16_t* Bt; int M, N, K; };

struct StaticOrder {
    int nM, nN, nwg, G, c, ntf;
    __host__ __device__ __forceinline__ void init(int M, int N, int G_, int c_, int K_ = 0) { nM = M / BM; nN = N / BM; nwg = nM * nN; G = G_; c = c_; ntf = K_ / BK; }
    __host__ __device__ __forceinline__ bool next(int i, Unit& u) const {
        const long L = (long)i * G + c; if (L >= nwg) return false;
        int wgid = (int)L; { const int q = nwg / NXCD, r = nwg % NXCD, xcd = wgid % NXCD, off = wgid / NXCD; wgid = (xcd < r ? xcd * (q + 1) : r * (q + 1) + (xcd - r) * q) + off; }
        const int nig = WGM * nN, gid = wgid / nig, fm = gid * WGM, gsz = (nM - fm) < WGM ? (nM - fm) : WGM;
        u.pm = fm + ((wgid % nig) % gsz); u.pn = (wgid % nig) / gsz; u.k0 = 0; u.nt = ntf; return true;
    }
    __device__ __forceinline__ void a_ready(const Unit&) const {}
    __device__ __forceinline__ void done(const Unit&) const {}
};

__device__ __forceinline__ unsigned cvt_pk_bf16(float lo, float hi) { unsigned r; asm volatile("v_cvt_pk_bf16_f32 %0, %1, %2" : "=v"(r) : "v"(lo), "v"(hi)); return r; }
typedef float f32x2 __attribute__((ext_vector_type(2)));
template <class Epi, class Sched, bool ALIGN_EPI = false, bool SP2 = false>
__device__ __forceinline__ void gemm_phase(PG8_LAS unsigned char* lds, const Gemm g, const Sched& S, const Epi& E) {
    int tid_l = threadIdx.x; asm volatile("" : "+v"(tid_l));
    const int tid = tid_l, wid = __builtin_amdgcn_readfirstlane(tid >> 6), lane = tid & 63, wr = wid >> 2, wc = wid & 3, fr = lane & 15, fq = lane >> 4;
    const int K = g.K;
    unsigned voffA[2], voffB[2];
#pragma unroll
    for (int i = 0; i < 2; ++i) { int R, C; stage_rc(tid * 16 + i * 8192, R, C); const int Rb = Epi::PERM ? ((R & ~31) + perm32(R & 31)) : R;
        voffA[i] = (unsigned)(R * K + C) * 2u; voffB[i] = (unsigned)(Rb * K + C) * 2u; }
    const size_t kstep = (size_t)(BK * 2);
    const size_t hstep = (size_t)HALF * K * 2;
    const size_t tstep = 2 * hstep;
    const unsigned ldsw = (unsigned)wid * 1024u;
    const int aoff = lds_byte(wr * 64 + fr, fq * 8), boff = lds_byte(wc * 32 + fr, fq * 8);
#define PG8_SA(b, h) (((b) * 2 + (h)) * HTB)
#define PG8_SB(b, h) ((4 + (b) * 2 + (h)) * HTB)
#define PG8_STAGE(bufoff, gbase, voff) do { _Pragma("unroll") for (int _i = 0; _i < 2; ++_i) \
        __builtin_amdgcn_global_load_lds((const unsigned*)((const char*)(gbase) + (voff)[_i]), (PG8_LAS unsigned*)(lds + (bufoff) + ldsw + _i * 8192), 16, 0, 0); } while (0)
#define PG8_STAGE_A(bufoff, gbase, voff) do { _Pragma("unroll") for (int _i = 0; _i < 2; ++_i) \
        __builtin_amdgcn_global_load_lds((const unsigned*)((const char*)(gbase) + (voff)[_i]), (PG8_LAS unsigned*)(lds + (bufoff) + ldsw + _i * 8192), 16, 0, Epi::A_AUX); } while (0)
#define PG8_LDA(dst, b, h) do { _Pragma("unroll") for (int m = 0; m < 4; ++m) _Pragma("unroll") for (int k = 0; k < 2; ++k) dst[m][k] = *(const PG8_LAS bf16x8*)(lds + PG8_SA(b, h) + aoff + m * 2048 + k * 1024); } while (0)
#define PG8_LDB(dst, b, h) do { _Pragma("unroll") for (int n = 0; n < 2; ++n) _Pragma("unroll") for (int k = 0; k < 2; ++k) dst[n][k] = *(const PG8_LAS bf16x8*)(lds + PG8_SB(b, h) + boff + n * 2048 + k * 1024); } while (0)
#define PG8_MMA(ai, bj, At, Bt) do { __builtin_amdgcn_s_setprio(1); _Pragma("unroll") for (int m = 0; m < 4; ++m) _Pragma("unroll") for (int n = 0; n < 2; ++n) _Pragma("unroll") for (int k = 0; k < 2; ++k) \
        acc[ai][bj][m][n] = __builtin_amdgcn_mfma_f32_16x16x32_bf16(Bt[n][k], At[m][k], acc[ai][bj][m][n], 0, 0, 0); __builtin_amdgcn_s_setprio(0); } while (0)
#define PG8_WAIT_V(n) asm volatile("s_waitcnt vmcnt(" #n ")" ::: "memory")
#define PG8_WAIT_L(n) asm volatile("s_waitcnt lgkmcnt(" #n ")" ::: "memory")
#define PG8_BAR __builtin_amdgcn_s_barrier()
#define PG8_SCHED __builtin_amdgcn_sched_barrier(0)
    Unit cur, nxt; int ui = 0;
    if (!S.next(0, cur)) return;
    f32x4 acc[2][2][4][2];
#pragma unroll
    for (int a = 0; a < 2; ++a)
#pragma unroll
        for (int b = 0; b < 2; ++b)
#pragma unroll
            for (int m = 0; m < 4; ++m)
#pragma unroll
                for (int n = 0; n < 2; ++n) acc[a][b][m][n] = (f32x4){0.f, 0.f, 0.f, 0.f};
    bf16x8 At[4][2], B0[2][2], B1[2][2];
    const char* cA = (const char*)g.A + (size_t)cur.pm * tstep + (size_t)cur.k0 * kstep; const char* cB = (const char*)g.Bt + (size_t)cur.pn * tstep + (size_t)cur.k0 * kstep;
    S.a_ready(cur);
    if constexpr (SP2) {
        PG8_STAGE(PG8_SB(0, 0), cB, voffB); PG8_STAGE(PG8_SB(0, 1), cB + hstep, voffB); PG8_STAGE_A(PG8_SA(0, 0), cA, voffA); PG8_STAGE_A(PG8_SA(0, 1), cA + hstep, voffA);
        if (wr == 1) PG8_BAR;
        PG8_WAIT_V(2); PG8_BAR;
        PG8_STAGE(PG8_SB(1, 0), cB + kstep, voffB); PG8_STAGE_A(PG8_SA(1, 0), cA + kstep, voffA); PG8_STAGE(PG8_SB(1, 1), cB + hstep + kstep, voffB);
        PG8_WAIT_V(6); PG8_BAR;
    } else {
        PG8_STAGE(PG8_SB(0, 0), cB, voffB); PG8_STAGE_A(PG8_SA(0, 0), cA, voffA); PG8_STAGE(PG8_SB(0, 1), cB + hstep, voffB); PG8_STAGE_A(PG8_SA(0, 1), cA + hstep, voffA);
        if (wr == 1) PG8_BAR;
        PG8_WAIT_V(4); PG8_BAR;
        PG8_STAGE(PG8_SB(1, 0), cB + kstep, voffB); PG8_STAGE_A(PG8_SA(1, 0), cA + kstep, voffA); PG8_STAGE(PG8_SB(1, 1), cB + hstep + kstep, voffB);
        PG8_WAIT_V(6); PG8_BAR;
    }
    for (;;) {
        const bool has_next = S.next(ui + 1, nxt);
        const char* nA = has_next ? (const char*)g.A + (size_t)nxt.pm * tstep + (size_t)nxt.k0 * kstep : cA; const char* nB = has_next ? (const char*)g.Bt + (size_t)nxt.pn * tstep + (size_t)nxt.k0 * kstep : cB;
        const int nt = cur.nt;
        for (int t = 0; t < nt; t += 2) {
            const bool last = (t == nt - 2);
            const char* a1 = cA + (size_t)(t + 1) * kstep;
            const char* a2 = last ? nA : cA + (size_t)(t + 2) * kstep; const char* b2 = last ? nB : cB + (size_t)(t + 2) * kstep;
            const char* a3 = a2 + kstep; const char* b3 = b2 + kstep;
            if (last && has_next) S.a_ready(nxt);
            if constexpr (SP2) {
            PG8_LDB(B0, 0, 0); PG8_LDB(B1, 0, 1); PG8_SCHED; PG8_LDA(At, 0, 0); PG8_STAGE_A(PG8_SA(1, 1), a1 + hstep, voffA);
            PG8_WAIT_V(8); PG8_WAIT_L(0); PG8_BAR; PG8_MMA(0, 0, At, B0); PG8_MMA(0, 1, At, B1); PG8_BAR; PG8_SCHED;
            PG8_LDA(At, 0, 1); PG8_STAGE(PG8_SB(0, 0), b2, voffB); PG8_STAGE(PG8_SB(0, 1), b2 + hstep, voffB); PG8_STAGE_A(PG8_SA(0, 0), a2, voffA);
            PG8_WAIT_V(8); PG8_WAIT_L(0); PG8_BAR; PG8_MMA(1, 0, At, B0); PG8_MMA(1, 1, At, B1); PG8_BAR; PG8_SCHED;
            PG8_LDB(B0, 1, 0); PG8_LDB(B1, 1, 1); PG8_SCHED; PG8_LDA(At, 1, 0); PG8_STAGE_A(PG8_SA(0, 1), a2 + hstep, voffA);
            PG8_WAIT_V(8); PG8_WAIT_L(0); PG8_BAR; PG8_MMA(0, 0, At, B0); PG8_MMA(0, 1, At, B1); PG8_BAR; PG8_SCHED;
            PG8_LDA(At, 1, 1); PG8_STAGE(PG8_SB(1, 0), b3, voffB); PG8_STAGE(PG8_SB(1, 1), b3 + hstep, voffB); PG8_STAGE_A(PG8_SA(1, 0), a3, voffA);
            PG8_WAIT_V(8); PG8_WAIT_L(0); PG8_BAR; PG8_MMA(1, 0, At, B0); PG8_MMA(1, 1, At, B1); PG8_BAR; PG8_SCHED;
            } else {
            PG8_LDB(B0, 0, 0); PG8_SCHED; PG8_LDA(At, 0, 0); PG8_STAGE_A(PG8_SA(1, 1), a1 + hstep, voffA);
            PG8_WAIT_L(8); PG8_BAR; PG8_WAIT_L(0); PG8_MMA(0, 0, At, B0); PG8_BAR; PG8_SCHED;
            PG8_LDB(B1, 0, 1); PG8_STAGE(PG8_SB(0, 0), b2, voffB);
            PG8_BAR; PG8_WAIT_L(0); PG8_MMA(0, 1, At, B1); PG8_BAR;
            PG8_LDA(At, 0, 1); PG8_STAGE_A(PG8_SA(0, 0), a2, voffA);
            PG8_BAR; PG8_WAIT_L(0); PG8_MMA(1, 0, At, B0); PG8_BAR; PG8_SCHED;
            PG8_STAGE(PG8_SB(0, 1), b2 + hstep, voffB);
            PG8_WAIT_V(6); PG8_BAR; PG8_MMA(1, 1, At, B1); PG8_BAR;
            PG8_LDB(B0, 1, 0); PG8_SCHED; PG8_LDA(At, 1, 0); PG8_STAGE_A(PG8_SA(0, 1), a2 + hstep, voffA);
            PG8_WAIT_L(8); PG8_BAR; PG8_WAIT_L(0); PG8_MMA(0, 0, At, B0); PG8_BAR; PG8_SCHED;
            PG8_LDB(B1, 1, 1); PG8_STAGE(PG8_SB(1, 0), b3, voffB);
            PG8_BAR; PG8_WAIT_L(0); PG8_MMA(0, 1, At, B1); PG8_BAR;
            PG8_LDA(At, 1, 1); PG8_STAGE_A(PG8_SA(1, 0), a3, voffA);
            PG8_BAR; PG8_WAIT_L(0); PG8_MMA(1, 0, At, B0); PG8_BAR; PG8_SCHED;
            PG8_STAGE(PG8_SB(1, 1), b3 + hstep, voffB);
            PG8_WAIT_V(6); PG8_BAR; PG8_MMA(1, 1, At, B1); PG8_BAR;
            }
        }
        if constexpr (ALIGN_EPI) { if (wr == 0) PG8_BAR; }
        if constexpr (!Epi::AFTER_DRAIN) { E(acc, cur, wr, wc, fr, fq); S.done(cur); }
        if (!has_next) break;
#pragma unroll
        for (int a = 0; a < 2; ++a)
#pragma unroll
            for (int b = 0; b < 2; ++b)
#pragma unroll
                for (int m = 0; m < 4; ++m)
#pragma unroll
                    for (int n = 0; n < 2; ++n) acc[a][b][m][n] = (f32x4){0.f, 0.f, 0.f, 0.f};
        cur = nxt; cA = nA; cB = nB; ++ui;
        if constexpr (ALIGN_EPI) { if (wr == 1) PG8_BAR; }
    }
    PG8_WAIT_V(0);
    if constexpr (!ALIGN_EPI) { if (wr == 0) PG8_BAR; }
    PG8_BAR;
    if constexpr (Epi::AFTER_DRAIN) { E.fused(acc, cur, wr, wc, fr, fq, lds, wid, lane); S.done(cur); }
#undef PG8_SA
#undef PG8_SB
#undef PG8_STAGE
#undef PG8_STAGE_A
#undef PG8_LDA
#undef PG8_LDB
#undef PG8_MMA
#undef PG8_WAIT_V
#undef PG8_WAIT_L
#undef PG8_BAR
#undef PG8_SCHED
}
}
namespace pg8 {
typedef unsigned u32x2 __attribute__((ext_vector_type(2)));
__device__ __forceinline__ unsigned pk_bf16(float lo, float hi) {
    typedef float f2_t __attribute__((ext_vector_type(2))); typedef __bf16 b2_t __attribute__((ext_vector_type(2)));
    f2_t v = {lo, hi}; b2_t b = __builtin_convertvector(v, b2_t); return __builtin_bit_cast(unsigned, b);
}
constexpr int E_T = 2064, E_M = 8 * 2064, E_DM = 2048, E_DFF = 5504;
struct EpiSwiglu {
    static constexpr bool PERM = true, AFTER_DRAIN = false; static constexpr int A_AUX = 0;
    bf16_t* act; const float* ss; long long skip;
    __device__ __forceinline__ void operator()(const f32x4 (&acc)[2][2][4][2], const Unit& u, int wr, int wc, int fr, int fq) const {
        if (skip) return;
        const int row0 = u.pm * BM + wr * 64 + fr; const int col0 = u.pn * 128 + wc * 32 + 8 * fq;
        float rs[2][4];
#pragma unroll
        for (int ai = 0; ai < 2; ++ai)
#pragma unroll
            for (int m = 0; m < 4; ++m) rs[ai][m] = ss[row0 + ai * HALF + m * 16];
#pragma unroll
        for (int ai = 0; ai < 2; ++ai)
#pragma unroll
            for (int m = 0; m < 4; ++m) {
                const int row = row0 + ai * HALF + m * 16;
                const float r = __builtin_amdgcn_rsqf(rs[ai][m] * (1.0f / 2048.0f) + 1e-6f);
                float o[8];
#pragma unroll
                for (int n = 0; n < 2; ++n)
#pragma unroll
                    for (int j = 0; j < 4; ++j) {
                        const float g = acc[ai][0][m][n][j] * r, up = acc[ai][1][m][n][j] * r;
                        const float sg = g * __builtin_amdgcn_rcpf(1.0f + __builtin_amdgcn_exp2f(-1.4426950408889634f * g));
                        o[n * 4 + j] = sg * up;
                    }
                u32x4 w; w.x = pk_bf16(o[0], o[1]); w.y = pk_bf16(o[2], o[3]); w.z = pk_bf16(o[4], o[5]); w.w = pk_bf16(o[6], o[7]);
                *(u32x4*)(act + (size_t)row * E_DFF + col0) = w;
            }
    }
};
struct EpiResid {
    static constexpr bool PERM = true, AFTER_DRAIN = false; static constexpr int A_AUX = 0;
    bf16_t* hb; float* ss_out; float* dout; float* part; float alpha; int ch;
    __device__ __forceinline__ void operator()(const f32x4 (&acc)[2][2][4][2], const Unit& u, int wr, int wc, int fr, int fq) const {
        const int row0 = u.pm * BM + wr * 64 + fr; const int col0 = u.pn * BM + wc * 32 + 8 * fq;
        if (u.pm == 64) {
            float* pp = part + ((size_t)(u.k0 / ch) * 128 + wr * 64 + fr) * E_DM + col0;
#pragma unroll
            for (int m = 0; m < 4; ++m)
#pragma unroll
                for (int bj = 0; bj < 2; ++bj)
#pragma unroll
                    for (int n = 0; n < 2; ++n) *(f32x4*)(pp + (size_t)(m * 16) * E_DM + bj * HALF + n * 4) = acc[0][bj][m][n];
            return;
        }
#pragma unroll
        for (int ai = 0; ai < 2; ++ai) {
            u32x4 hwa[4][2];
#pragma unroll
            for (int m = 0; m < 4; ++m)
#pragma unroll
                for (int bj = 0; bj < 2; ++bj) hwa[m][bj] = *(const u32x4*)(hb + (size_t)(row0 + ai * HALF + m * 16) * E_DM + col0 + bj * HALF);
            asm volatile("" ::: "memory");
#pragma unroll
            for (int m = 0; m < 4; ++m) {
                const int row = row0 + ai * HALF + m * 16; const size_t off = (size_t)row * E_DM + col0;
                u32x4 hw[2];
#pragma unroll
                for (int bj = 0; bj < 2; ++bj) hw[bj] = hwa[m][bj];
                f32x4 v[2][2];
#pragma unroll
                for (int bj = 0; bj < 2; ++bj)
#pragma unroll
                    for (int n = 0; n < 2; ++n) { const unsigned w0 = hw[bj][2 * n], w1 = hw[bj][2 * n + 1];
                        const f32x4 hv = (f32x4){__uint_as_float(w0 << 16), __uint_as_float(w0 & 0xffff0000u), __uint_as_float(w1 << 16), __uint_as_float(w1 & 0xffff0000u)};
                        v[bj][n] = hv + acc[ai][bj][m][n] * alpha; }
                if (dout) {
                    const int b = row / E_T, t = row - b * E_T;
                    if (t >= 16 && row < E_M) { float* d = dout + ((size_t)(b * 2048 + t - 16)) * E_DM + col0;
#pragma unroll
                        for (int bj = 0; bj < 2; ++bj)
#pragma unroll
                            for (int n = 0; n < 2; ++n) *(f32x4*)(d + bj * HALF + n * 4) = v[bj][n]; }
                } else {
                    float sq = 0.f;
#pragma unroll
                    for (int bj = 0; bj < 2; ++bj) { const f32x4 x = v[bj][0], y = v[bj][1];
                        u32x4 w; w.x = pk_bf16(x[0], x[1]); w.y = pk_bf16(x[2], x[3]); w.z = pk_bf16(y[0], y[1]); w.w = pk_bf16(y[2], y[3]); *(u32x4*)(hb + off + bj * HALF) = w;
                        sq += ((x[0] * x[0] + x[1] * x[1]) + (x[2] * x[2] + x[3] * x[3])) + ((y[0] * y[0] + y[1] * y[1]) + (y[2] * y[2] + y[3] * y[3])); }
                    sq += __shfl_xor(sq, 16); sq += __shfl_xor(sq, 32);
                    if (fq == 0) atomicAdd(ss_out + row, sq);
                }
            }
            asm volatile("" ::: "memory");
        }
    }
};
struct EpiScale {
    static constexpr bool PERM = false, AFTER_DRAIN = false; static constexpr int A_AUX = 0;
    bf16_t* pb; float* pf; const float* ss; int ldb, nbf, ldf, pad_;
    __device__ __forceinline__ void operator()(const f32x4 (&acc)[2][2][4][2], const Unit& u, int wr, int wc, int fr, int fq) const {
        const int row0 = u.pm * BM + wr * 64 + fr; const int col0 = wc * 32 + 4 * fq;
        float rs[2][4];
#pragma unroll
        for (int ai = 0; ai < 2; ++ai)
#pragma unroll
            for (int m = 0; m < 4; ++m) rs[ai][m] = ss[row0 + ai * HALF + m * 16];
#pragma unroll
        for (int ai = 0; ai < 2; ++ai)
#pragma unroll
            for (int m = 0; m < 4; ++m) {
                const int row = row0 + ai * HALF + m * 16;
                const float r = __builtin_amdgcn_rsqf(rs[ai][m] * (1.0f / 2048.0f) + 1e-6f);
                if (u.pn < nbf) { bf16_t* p = pb + (size_t)row * ldb + u.pn * BM + col0;
#pragma unroll
                    for (int bj = 0; bj < 2; ++bj)
#pragma unroll
                        for (int n = 0; n < 2; ++n) { const f32x4 x = acc[ai][bj][m][n] * r; u32x2 w; w.x = pk_bf16(x[0], x[1]); w.y = pk_bf16(x[2], x[3]); *(u32x2*)(p + bj * HALF + n * 16) = w; }
                } else { float* p = pf + (size_t)row * ldf + (u.pn - nbf) * BM + col0;
#pragma unroll
                    for (int bj = 0; bj < 2; ++bj)
#pragma unroll
                        for (int n = 0; n < 2; ++n) *(f32x4*)(p + bj * HALF + n * 16) = acc[ai][bj][m][n] * r;
                }
            }
    }
};
struct ResidOrder {
    StaticOrder so; int G, c, ntf, ch, nch;
    __device__ __forceinline__ void init(int K, int G_, int c_) { so.init(16384, 2048, G_, c_, K); G = G_; c = c_; ntf = K / BK; ch = 4; nch = (ntf + ch - 1) / ch; }
    __device__ __forceinline__ bool next(int i, Unit& u) const {
        const int L = i * G + c;
        if (L < 512) return so.next(i, u);
        const int p = L - 512; if (p >= 8 * nch) return false;
        u.pm = 64; u.pn = p & 7; const int chunk = p >> 3; u.k0 = chunk * ch; u.nt = (ntf - u.k0) < ch ? (ntf - u.k0) : ch; return true;
    }
    __device__ __forceinline__ void a_ready(const Unit&) const {}
    __device__ __forceinline__ void done(const Unit&) const {}
};
}
#define DI __device__ __forceinline__
#define LAS __attribute__((address_space(3)))
#define GAS __attribute__((address_space(1)))
typedef unsigned short bf16_t;
typedef short bf16x8 __attribute__((ext_vector_type(8)));
typedef float f32x4 __attribute__((ext_vector_type(4)));
typedef float f32x16 __attribute__((ext_vector_type(16)));
typedef unsigned u32x4 __attribute__((ext_vector_type(4)));
typedef unsigned u32x2 __attribute__((ext_vector_type(2)));
typedef unsigned long long u64;
using pg8::pk_bf16;

constexpr int NB = 8, DM = 2048, T = 2064, M = NB * T, MP = 16640, DFF = 5504, TP = 2112;
constexpr int AINP = 4352, MW = 66;
constexpr float EPS = 1e-6f;
constexpr float QSCALE_A = 0.12751743082459868f;
constexpr float QSCALE_B = 0.18033688011112042f;
constexpr float LOG2E = 1.4426950408889634f;
constexpr int NWAVES = 8, LDS_BYTES = 147456, PTRTAB_OFF = LDS_BYTES - 256;

constexpr size_t al256(size_t x) { return (x + 255) & ~(size_t)255; }
constexpr size_t SZ_WGU = (size_t)11008 * 2048 * 2, SZ_WD = (size_t)2048 * 5504 * 2, SZ_SQ = (size_t)2048 * 2048 * 2;
constexpr size_t O_H = 0;
constexpr size_t O_R1 = O_H + (size_t)MP * DM * 4;
constexpr size_t O_PROJF = O_R1 + (size_t)MP * 3072 * 2;
constexpr size_t SZ_R1 = (size_t)MP * 3072 * 2 + (size_t)MP * 1280 * 4;
static_assert(SZ_R1 >= (size_t)MP * DFF * 2 && SZ_R1 >= (size_t)MP * DM * 4, "R1");
constexpr size_t O_QO = O_R1 + SZ_R1;
constexpr size_t O_KA = O_QO + (size_t)MP * DM * 2;
constexpr size_t O_VTA = O_KA + (size_t)MP * 512 * 2;
constexpr size_t O_KI = O_VTA + (size_t)NB * 4 * 128 * TP * 2;
constexpr size_t O_WI = O_KI + (size_t)MP * 64 * 2;
constexpr size_t O_MASK = O_WI + (size_t)MP * 16 * 4;
constexpr size_t O_KB = al256(O_MASK + (size_t)MP * MW * 4);
constexpr size_t O_VTB = O_KB + (size_t)MP * 256 * 2;
constexpr size_t O_WGU_B = al256(O_VTB + (size_t)NB * 4 * 64 * TP * 2);
constexpr size_t O_WD_B = O_WGU_B + SZ_WGU;
constexpr size_t O_WOA = O_WD_B + SZ_WD;
constexpr size_t O_WKV = O_WOA + SZ_SQ;
constexpr size_t O_WQB = O_WKV + (size_t)512 * 2048 * 2;
constexpr size_t O_WOB = O_WQB + SZ_SQ;
constexpr size_t O_WIN = O_WOB + SZ_SQ;
constexpr size_t O_WD_A = O_WIN + (size_t)AINP * 2048 * 2;
constexpr size_t O_WGU_A = O_WD_A + SZ_WD;
constexpr size_t O_HB = O_WGU_A + SZ_WGU;
constexpr size_t O_SS = O_HB + (size_t)MP * DM * 2;
constexpr size_t O_BAR = al256(O_SS + (size_t)8 * MP * 4);
constexpr size_t WS_END = O_BAR + 16384;
static_assert(WS_END <= (size_t)760 * 1000 * 1000, "workspace budget");

__device__ const float INV16[16] = {1.000000000e+00f, 4.403665960e-01f, 1.939227432e-01f, 8.539710194e-02f, 3.760603070e-02f, 1.656043902e-02f, 7.292664610e-03f, 3.211445874e-03f,
                                    1.414213562e-03f, 6.227723788e-04f, 2.742481884e-04f, 1.207697351e-04f, 5.318296098e-05f, 2.341999971e-05f, 1.031338616e-05f, 4.541670478e-06f};

struct Frame {
    LAS unsigned char* lds; int tid, lane, wave, G, c, gw, NGW, cgw, cNGW, cnt_st, cmode;
    float* out; unsigned char* ws;
    DI const float* in(int k) const { return (const float*)((const GAS float*)(*(const LAS unsigned long long*)(lds + PTRTAB_OFF + 8 * k))); }
};
DI float bf2f(bf16_t b) { return __uint_as_float((unsigned)b << 16); }
DI float wave_sum(float v) {
#pragma unroll
    for (int o = 1; o < 64; o <<= 1) v += __shfl_xor(v, o);
    return v;
}
DI void rope_cs(float tpos, float inv, float& cs, float& sn) {
    const float ang = tpos * inv; double rv = (double)ang * 0.15915494309189535; rv -= __builtin_rint(rv);
    const float fr = (float)rv; cs = __builtin_amdgcn_cosf(fr); sn = __builtin_amdgcn_sinf(fr);
}
DI int perm16(int t) { return (t & ~15) | (t & 3) | ((t & 4) << 1) | ((t & 8) >> 1); }

DI void cvt_item(const float* W, int ldw, int N, const float* gain, bf16_t* WT, int K, int mode, int item, int nblk, LAS float* scr, int lane, int nt_st) {
    const int kb = item / nblk, nb = item - kb * nblk, k0 = 64 * kb, n0 = 64 * nb;
    const int cc = n0 + (lane & 15) * 4; const bool ok = cc < N;
    f32x4 v[16]; float gv[16];
#pragma unroll
    for (int i = 0; i < 16; ++i) { const int kk = 4 * i + (lane >> 4); v[i] = (f32x4){0.f, 0.f, 0.f, 0.f}; if (ok) v[i] = __builtin_nontemporal_load((const f32x4*)(W + (size_t)(k0 + kk) * ldw + cc)); gv[i] = gain ? gain[k0 + kk] : 1.0f; }
#pragma unroll
    for (int i = 0; i < 16; ++i) { const int kk = 4 * i + (lane >> 4); LAS float* d = scr + kk * 65 + (lane & 15) * 4;
        d[0] = v[i][0] * gv[i]; d[1] = v[i][1] * gv[i]; d[2] = v[i][2] * gv[i]; d[3] = v[i][3] * gv[i]; }
    asm volatile("s_waitcnt lgkmcnt(0)" ::: "memory");
    const int rbase = (mode == 0) ? n0 : ((n0 >> 7) * 256 + (n0 & 127) + (mode == 2 ? 128 : 0));
#pragma unroll
    for (int j = 0; j < 8; ++j) { const int idx = lane + 64 * j, n = idx >> 3, ch = idx & 7; const LAS float* s = scr + (8 * ch) * 65 + n;
        u32x4 o; o.x = pk_bf16(s[0 * 65], s[1 * 65]); o.y = pk_bf16(s[2 * 65], s[3 * 65]); o.z = pk_bf16(s[4 * 65], s[5 * 65]); o.w = pk_bf16(s[6 * 65], s[7 * 65]);
        if (nt_st) __builtin_nontemporal_store(o, (u32x4*)(WT + (size_t)(rbase + n) * K + k0 + 8 * ch)); else *(u32x4*)(WT + (size_t)(rbase + n) * K + k0 + 8 * ch) = o; }
    asm volatile("s_waitcnt lgkmcnt(0)" ::: "memory");
}
DI void cvt_job(Frame& F, const float* W, int ldw, int N, int Npad, const float* gain, bf16_t* WT, int K, int mode) {
    LAS float* scr = (LAS float*)(F.lds + F.wave * 16640);
    const int nblk = Npad / 64, nitems = (K / 64) * nblk;
    for (int v = F.cgw;; v += F.cNGW) { const int it = (F.cmode == 0) ? v : (F.cmode == 1) ? ((v >> 2) * 5 + (v & 3)) : (v * 5 + 4); if (it >= nitems) break;
        cvt_item(W, ldw, N, gain, WT, K, mode, it, nblk, scr, F.lane, F.cnt_st); }
}
DI void cvt_ffn(Frame& F, const float* nrm, const float* wg, const float* wu, const float* wd, int layer, bf16_t* WGU, bf16_t* WD) {
    cvt_job(F, wg + (size_t)layer * 2048 * DFF, DFF, DFF, DFF, nrm + layer * 2048, WGU, 2048, 1);
    cvt_job(F, wu + (size_t)layer * 2048 * DFF, DFF, DFF, DFF, nrm + layer * 2048, WGU, 2048, 2);
    cvt_job(F, wd + (size_t)layer * DFF * 2048, 2048, 2048, 2048, nullptr, WD, DFF, 0);
}

DI void p_prologue(Frame& F, bool zero_bar) {
    unsigned char* ws = F.ws;
    cvt_ffn(F, F.in(2), F.in(3), F.in(4), F.in(5), 0, (bf16_t*)(ws + O_WGU_A), (bf16_t*)(ws + O_WD_A));
    cvt_job(F, F.in(11), 4176, 4176, AINP, F.in(10), (bf16_t*)(ws + O_WIN), 2048, 0);
    cvt_job(F, F.in(15), 2048, 2048, 2048, nullptr, (bf16_t*)(ws + O_WOA), 2048, 0);
    cvt_job(F, F.in(17), 512, 512, 512, F.in(16), (bf16_t*)(ws + O_WKV), 2048, 0);
    cvt_job(F, F.in(20), 2048, 2048, 2048, F.in(19), (bf16_t*)(ws + O_WQB), 2048, 0);
    cvt_job(F, F.in(23), 2048, 2048, 2048, nullptr, (bf16_t*)(ws + O_WOB), 2048, 0);
    float* ss = (float*)(ws + O_SS);
    for (int i = F.gw * 64 + F.lane; i < 7 * MP; i += F.NGW * 64) ss[MP + i] = 0.f;
    if (F.c == 0 && zero_bar) for (int i = F.tid; i < 4096; i += NWAVES * 64) ((unsigned*)(ws + O_BAR))[i] = 0u;
    bf16_t* hb = (bf16_t*)(ws + O_HB);
    const float* x = F.in(0); const float* meta = F.in(1);
    for (int m = F.gw; m < MP; m += F.NGW) {
        const int b = m / T, t = m - b * T;
        const float* src = (t < 16) ? meta + (size_t)t * DM : x + ((size_t)(b * 2048 + t - 16)) * DM;
        const bool valid = m < M; float s = 0.f;
#pragma unroll
        for (int j = 0; j < 8; ++j) {
            f32x4 v = (f32x4){0.f, 0.f, 0.f, 0.f}; if (valid) v = __builtin_nontemporal_load((const f32x4*)(src + j * 256 + F.lane * 4));
            u32x2 w; w.x = pk_bf16(v[0], v[1]); w.y = pk_bf16(v[2], v[3]); *(u32x2*)(hb + (size_t)m * DM + j * 256 + F.lane * 4) = w;
            s += (v[0] * v[0] + v[1] * v[1]) + (v[2] * v[2] + v[3] * v[3]);
        }
        s = wave_sum(s); if (F.lane == 0) ss[m] = s;
    }
}

DI void head128_norm_rope(f32x4& v, const f32x4 g4, const float (&cs)[4], const float (&sn)[4], int lane) {
    float s = (v[0] * v[0] + v[1] * v[1]) + (v[2] * v[2] + v[3] * v[3]);
    s += __shfl_xor(s, 1); s += __shfl_xor(s, 2); s += __shfl_xor(s, 4); s += __shfl_xor(s, 8); s += __shfl_xor(s, 16);
    const float rn = __builtin_amdgcn_rsqf(s * (1.0f / 128.0f) + EPS);
    const int sub = lane & 31;
#pragma unroll
    for (int c = 0; c < 4; ++c) { const float y = v[c] * rn * g4[c]; const float p = __shfl_xor(y, 4);
        v[c] = (sub < 4) ? (y * cs[c] - p * sn[c]) : ((sub < 8) ? (y * cs[c] + p * sn[c]) : y); }
}
template <bool NORM> DI void head64_norm_rope(f32x4& v, const f32x4 g4, const float (&cs)[4], const float (&sn)[4], int lane) {
    float rn = 1.0f;
    if (NORM) { float s = (v[0] * v[0] + v[1] * v[1]) + (v[2] * v[2] + v[3] * v[3]);
        s += __shfl_xor(s, 1); s += __shfl_xor(s, 2); s += __shfl_xor(s, 4); s += __shfl_xor(s, 8);
        rn = __builtin_amdgcn_rsqf(s * (1.0f / 64.0f) + EPS); }
    const int l16 = lane & 15;
#pragma unroll
    for (int c = 0; c < 4; ++c) { const float y = NORM ? v[c] * rn * g4[c] : v[c]; const float p = __shfl_xor(y, 2);
        v[c] = (l16 < 2) ? (y * cs[c] - p * sn[c]) : ((l16 < 4) ? (y * cs[c] + p * sn[c]) : y); }
}
DI void store4_bf16(bf16_t* p, const f32x4 v, float sc) { u32x2 w; w.x = pk_bf16(v[0] * sc, v[1] * sc); w.y = pk_bf16(v[2] * sc, v[3] * sc); *(u32x2*)p = w; }
DI f32x4 load4_bf16(const bf16_t* p) { const u32x2 w = *(const u32x2*)p; return (f32x4){__uint_as_float(w.x << 16), __uint_as_float(w.x & 0xffff0000u), __uint_as_float(w.y << 16), __uint_as_float(w.y & 0xffff0000u)}; }
DI void zero_vt_pad(Frame& F, bf16_t* vt, int nrows, int gw, int NGW) {
    for (int rw = gw; rw < nrows; rw += NGW) if (F.lane < 6) { unsigned z = 0u; asm volatile("" : "+v"(z)); *(u32x4*)(vt + (size_t)rw * TP + T + F.lane * 8) = (u32x4){z, z, z, z}; }
}

template <int NV, bool SRC_F32> DI void vt_transpose(Frame& F, const void* src, int ld, int col0, bf16_t* vT, int ic, int iG) {
    constexpr int NCH = NV / 8, TPG = NCH * 4, GPW = (NWAVES * 64) / TPG, NGRP = NB * (T / 16);
    const int sub = F.tid / TPG, lt = F.tid % TPG, ch = lt >> 2, q = lt & 3;
    for (int g0 = ic * GPW; g0 < NGRP; g0 += iG * GPW) {
        const int g = g0 + sub; if (g >= NGRP) continue;
        const int b = g / (T / 16), gi = g - b * (T / 16); const int t0 = gi * 16; const size_t row0 = (size_t)b * T + t0 + 4 * q;
        u32x4 v[4];
#pragma unroll
        for (int kk = 0; kk < 4; ++kk) {
            if (SRC_F32) { const float* p = (const float*)src + (row0 + kk) * ld + col0 + ch * 8; const f32x4 a = *(const f32x4*)p, c2 = *(const f32x4*)(p + 4);
                v[kk].x = pk_bf16(a[0], a[1]); v[kk].y = pk_bf16(a[2], a[3]); v[kk].z = pk_bf16(c2[0], c2[1]); v[kk].w = pk_bf16(c2[2], c2[3]); }
            else v[kk] = *(const u32x4*)((const bf16_t*)src + (row0 + kk) * ld + col0 + ch * 8);
        }
        const int pos = t0 + ((q & 1) << 3) + ((q & 2) << 1);
        bf16_t* dst = vT + ((size_t)b * NV + ch * 8) * TP + pos;
#pragma unroll
        for (int j = 0; j < 8; ++j) {
            unsigned e[4];
#pragma unroll
            for (int kk = 0; kk < 4; ++kk) e[kk] = (j & 1) ? (v[kk][j >> 1] >> 16) : (v[kk][j >> 1] & 0xffffu);
            u32x2 w; w.x = e[0] | (e[1] << 16); w.y = e[2] | (e[3] << 16);
            *(u32x2*)(dst + (size_t)j * TP) = w;
        }
    }
}

DI f32x4 unpack4(const u32x2 w) { return (f32x4){__uint_as_float(w.x << 16), __uint_as_float(w.x & 0xffff0000u), __uint_as_float(w.y << 16), __uint_as_float(w.y & 0xffff0000u)}; }
DI void p_post_a(Frame& F) {
    unsigned char* ws = F.ws; const int lane = F.lane;
    const bf16_t* projb = (const bf16_t*)(ws + O_R1); const float* projf = (const float*)(ws + O_PROJF);
    bf16_t* qo = (bf16_t*)(ws + O_QO); bf16_t* kA = (bf16_t*)(ws + O_KA); bf16_t* vT = (bf16_t*)(ws + O_VTA);
    bf16_t* ki = (bf16_t*)(ws + O_KI); float* wi = (float*)(ws + O_WI);
    const int sub = lane & 31, l16 = lane & 15;
    const f32x4 gq = *(const f32x4*)(F.in(12) + sub * 4), gk = *(const f32x4*)(F.in(13) + sub * 4), gi = *(const f32x4*)(F.in(14) + l16 * 4);
    float inv_a[4], inv_i[4];
#pragma unroll
    for (int c = 0; c < 4; ++c) { inv_a[c] = INV16[(sub & 3) * 4 + c]; inv_i[c] = INV16[2 * ((lane & 1) * 4 + c)]; }
    u32x2 rb[12]; f32x4 rf[5]; float rw = 0.f;
#define PA_LOAD(mm) do { const bf16_t* pb_ = projb + (size_t)(mm) * 3072; const float* pf_ = projf + (size_t)(mm) * 1280; \
        _Pragma("unroll") for (int i_ = 8; i_ < 10; ++i_) rb[i_] = *(const u32x2*)(pb_ + i_ * 256 + lane * 4); \
        rf[4] = *(const f32x4*)(pf_ + 1024 + l16 * 4); rw = pf_[1088 + l16]; } while (0)
    int m = F.gw; if (m < MP) PA_LOAD(m);
    for (; m < MP; m += F.NGW) {
        u32x2 cb[12]; f32x4 cf[5]; const float cw = rw;
#pragma unroll
        for (int i = 8; i < 10; ++i) cb[i] = rb[i];
        cf[4] = rf[4];
        if (m + F.NGW < MP) PA_LOAD(m + F.NGW);
        const int b = m / T, t = m - b * T; const bool valid = m < M; const float tp = valid ? (float)t : 0.f;
        float csa[4], sna[4], csi[4], sni[4];
#pragma unroll
        for (int c = 0; c < 4; ++c) { rope_cs(tp, inv_a[c], csa[c], sna[c]); rope_cs(tp, inv_i[c], csi[c], sni[c]); }
#pragma unroll
        for (int it = 0; it < 2; ++it) { f32x4 v = unpack4(cb[8 + it]); head128_norm_rope(v, gk, csa, sna, lane); store4_bf16(kA + (size_t)m * 512 + it * 256 + lane * 4, v, 1.0f); }
        { f32x4 v = cf[4]; head64_norm_rope<true>(v, gi, csi, sni, lane); if (lane < 16) store4_bf16(ki + (size_t)m * 64 + lane * 4, v, 1.0f); }
        if (lane < 16) wi[(size_t)m * 16 + lane] = cw * 0.03125f;
    }
#undef PA_LOAD
    vt_transpose<512, false>(F, projb, 3072, 2560, vT, F.c, F.G);
    zero_vt_pad(F, vT, NB * 4 * 128, F.gw, F.NGW);
}

DI void unpack8(const u32x4 w, float (&x)[8]) {
#pragma unroll
    for (int i = 0; i < 4; ++i) { x[2 * i] = __uint_as_float(w[i] << 16); x[2 * i + 1] = __uint_as_float(w[i] & 0xffff0000u); }
}
DI bf16x8 pack8(const float (&x)[8], float sc) { u32x4 w; w.x = pk_bf16(x[0] * sc, x[1] * sc); w.y = pk_bf16(x[2] * sc, x[3] * sc); w.z = pk_bf16(x[4] * sc, x[5] * sc); w.w = pk_bf16(x[6] * sc, x[7] * sc); return __builtin_bit_cast(bf16x8, w); }
DI void qprep128(const bf16_t* qrow, const float* gain, float tpos, int h, bf16x8 (&qf)[8]) {
    float x[8][8]; float ss = 0.f;
#pragma unroll
    for (int s = 0; s < 8; ++s) { unpack8(*(const u32x4*)(qrow + 16 * s + 8 * h), x[s]);
#pragma unroll
        for (int j = 0; j < 8; ++j) ss += x[s][j] * x[s][j]; }
    ss += __shfl_xor(ss, 32);
    const float rn = __builtin_amdgcn_rsqf(ss * (1.0f / 128.0f) + EPS);
#pragma unroll
    for (int s = 0; s < 8; ++s) { const f32x4 g0 = *(const f32x4*)(gain + 16 * s + 8 * h), g1 = *(const f32x4*)(gain + 16 * s + 8 * h + 4);
#pragma unroll
        for (int j = 0; j < 4; ++j) { x[s][j] *= rn * g0[j]; x[s][4 + j] *= rn * g1[j]; } }
#pragma unroll
    for (int j = 0; j < 8; ++j) { float cs, sn; rope_cs(tpos, INV16[8 * h + j], cs, sn); const float x1 = x[0][j], x2 = x[1][j]; x[0][j] = x1 * cs - x2 * sn; x[1][j] = x2 * cs + x1 * sn; }
#pragma unroll
    for (int s = 0; s < 8; ++s) qf[s] = pack8(x[s], QSCALE_A);
}
DI void qprep64(const bf16_t* qrow, const float* gain, float tpos, int h, bf16x8 (&qf)[4]) {
    float x[4][8]; float ss = 0.f;
#pragma unroll
    for (int s = 0; s < 4; ++s) { unpack8(*(const u32x4*)(qrow + 16 * s + 8 * h), x[s]);
#pragma unroll
        for (int j = 0; j < 8; ++j) ss += x[s][j] * x[s][j]; }
    ss += __shfl_xor(ss, 32);
    const float rn = __builtin_amdgcn_rsqf(ss * (1.0f / 64.0f) + EPS);
#pragma unroll
    for (int s = 0; s < 4; ++s) { const f32x4 g0 = *(const f32x4*)(gain + 16 * s + 8 * h), g1 = *(const f32x4*)(gain + 16 * s + 8 * h + 4);
#pragma unroll
        for (int j = 0; j < 4; ++j) { x[s][j] *= rn * g0[j]; x[s][4 + j] *= rn * g1[j]; } }
#pragma unroll
    for (int j = 0; j < 8; ++j) { float cs, sn; rope_cs(tpos, INV16[2 * j], cs, sn); const float y = x[0][j]; const float p = __shfl_xor(y, 32); x[0][j] = h ? (y * cs + p * sn) : (y * cs - p * sn); }
#pragma unroll
    for (int s = 0; s < 4; ++s) qf[s] = pack8(x[s], QSCALE_B);
}

template <int J> DI void select_mask(const LAS float* scq, int t, int lane, unsigned* mrow) {
    unsigned u[J];
#pragma unroll
    for (int j = 0; j < J; ++j) { const int key = lane + 64 * j; const unsigned bits = __float_as_uint(scq[key]);
        const unsigned uu = bits ^ ((unsigned)((int)bits >> 31) | 0x80000000u); u[j] = (key <= t) ? uu : 0u; }
    unsigned thr = 0u;
    if (t >= 256) {
        for (int bit = 31; bit >= 0; --bit) { const unsigned cand = thr | (1u << bit); int cnt = 0;
#pragma unroll
            for (int j = 0; j < J; ++j) cnt += __popcll(__ballot(u[j] >= cand));
            if (cnt >= 256) thr = cand;
            if (cnt == 256) break; }
    }
    u64 mine = 0ull;
#pragma unroll
    for (int j = 0; j < J; ++j) { const u64 bal = __ballot((u[j] >= thr) && (lane + 64 * j <= t)); if (lane == j) mine = bal; }
    if (lane < 33) ((u64*)mrow)[lane] = mine;
}

DI void p_index(Frame& F) {
    unsigned char* ws = F.ws; const int lane = F.lane, r = lane & 31, h = lane >> 5, tid = F.tid;
    const bf16_t* ki = (const bf16_t*)(ws + O_KI); const float* wi = (const float*)(ws + O_WI);
    unsigned* maskbits = (unsigned*)(ws + O_MASK);
    LAS float* sc = (LAS float*)(F.lds) + F.wave * (2 * TP);
    constexpr int KT_OFF = NWAVES * 2 * TP * 4, KTS = 144;
    static_assert(KT_OFF + 64 * KTS <= PTRTAB_OFF, "index LDS map");
    LAS unsigned char* kt_lds = F.lds + KT_OFF;
    constexpr int NGRP = T / 16, NITEMS = NB * NGRP;
    for (int i = 0;; ++i) {
        const int k = i * F.G + ((i & 1) ? (F.G - 1 - F.c) : F.c); if (k >= NITEMS) break;
        const int b = k & 7, gi = NGRP - 1 - (k >> 3); const int t0 = 16 * gi + 2 * F.wave; const size_t m0 = (size_t)b * T + t0;
        const int nkt = ((16 * gi + 15) >> 6) + 1;
        bf16x8 af[4];
        { const float* qrow = (const float*)(ws + O_PROJF) + (m0 + (r >> 4)) * 1280 + (r & 15) * 64 + 8 * h; const float tpos = (float)(t0 + (r >> 4));
#pragma unroll
          for (int s = 0; s < 4; ++s) { const f32x4 v0 = *(const f32x4*)(qrow + 16 * s), v1 = *(const f32x4*)(qrow + 16 * s + 4);
              float x[8] = {v0[0], v0[1], v0[2], v0[3], v1[0], v1[1], v1[2], v1[3]};
              if (s == 0) {
#pragma unroll
                  for (int j = 0; j < 8; ++j) { float cs, sn; rope_cs(tpos, INV16[2 * j], cs, sn); const float y = x[j]; const float p = __shfl_xor(y, 32); x[j] = h ? (y * cs + p * sn) : (y * cs - p * sn); } }
              af[s] = pack8(x, 1.0f); } }
        float w[16];
#pragma unroll
        for (int j = 0; j < 16; ++j) w[j] = wi[(m0 + (j >> 3)) * 16 + (j & 3) + 8 * ((j >> 2) & 1) + 4 * h];
        const bf16_t* kg = ki + ((size_t)b * T + (tid >> 3)) * 64 + (tid & 7) * 8;
        u32x4 kreg = *(const u32x4*)kg, kreg1 = *(const u32x4*)(kg + (size_t)((1 < nkt) ? 1 : 0) * 64 * 64), kreg2 = *(const u32x4*)(kg + (size_t)((2 < nkt) ? 2 : 0) * 64 * 64);
        for (int kt = 0; kt < nkt; ++kt) {
            __syncthreads();
            *(LAS u32x4*)(kt_lds + (tid >> 3) * KTS + (tid & 7) * 16) = kreg;
            __syncthreads();
            kreg = kreg1; kreg1 = kreg2; { const int kn = (kt + 3 < nkt) ? kt + 3 : nkt - 1; kreg2 = *(const u32x4*)(kg + (size_t)kn * 64 * 64); }
            bf16x8 bq[2][4];
#pragma unroll
            for (int kb = 0; kb < 2; ++kb)
#pragma unroll
                for (int s = 0; s < 4; ++s) bq[kb][s] = *(const LAS bf16x8*)(kt_lds + (32 * kb + r) * KTS + (16 * s + 8 * h) * 2);
            f32x16 acc[2];
#pragma unroll
            for (int kb = 0; kb < 2; ++kb)
#pragma unroll
                for (int j = 0; j < 16; ++j) acc[kb][j] = 0.f;
#pragma unroll
            for (int s = 0; s < 4; ++s)
#pragma unroll
                for (int kb = 0; kb < 2; ++kb) acc[kb] = __builtin_amdgcn_mfma_f32_32x32x16_bf16(af[s], bq[kb][s], acc[kb], 0, 0, 0);
#pragma unroll
            for (int kb = 0; kb < 2; ++kb) {
                float s0 = 0.f, s1 = 0.f;
#pragma unroll
                for (int j = 0; j < 8; ++j) { s0 += fmaxf(acc[kb][j], 0.f) * w[j]; s1 += fmaxf(acc[kb][8 + j], 0.f) * w[8 + j]; }
                const float send = h ? s0 : s1; const float recv = __shfl_xor(send, 32); const float mine = (h ? s1 : s0) + recv;
                sc[h * TP + kt * 64 + kb * 32 + r] = mine;
            }
        }
        for (int q = 0; q < 2; ++q) { const int t = t0 + q; unsigned* mrow = maskbits + (m0 + q) * MW;
            if (t < 64 * 17) select_mask<17>(sc + q * TP, t, lane, mrow); else select_mask<33>(sc + q * TP, t, lane, mrow); }
    }
}

template <int D, int KS, int VS, int NKB> DI void attn_step(const bf16x8 (&qf)[D / 16], const LAS unsigned char* Kt, const LAS unsigned char* Vt, const unsigned (&mw)[NKB], float& mrun, float& lrun, f32x16 (&o)[D / 32], int r, int h) {
    f32x16 s[NKB];
#pragma unroll
    for (int kb = 0; kb < NKB; ++kb)
#pragma unroll
        for (int j = 0; j < 16; ++j) s[kb][j] = 0.f;
    constexpr int KBATCH = 4 / NKB;
#pragma unroll
    for (int k0 = 0; k0 < D / 16; k0 += KBATCH) {
        bf16x8 a[NKB][KBATCH];
#pragma unroll
        for (int kb = 0; kb < NKB; ++kb)
#pragma unroll
            for (int kk = 0; kk < KBATCH; ++kk) a[kb][kk] = *(const LAS bf16x8*)(Kt + (32 * kb + r) * KS + (16 * (k0 + kk) + 8 * h) * 2);
        asm volatile("" ::: "memory");
#pragma unroll
        for (int kk = 0; kk < KBATCH; ++kk)
#pragma unroll
            for (int kb = 0; kb < NKB; ++kb) s[kb] = __builtin_amdgcn_mfma_f32_32x32x16_bf16(a[kb][kk], qf[k0 + kk], s[kb], 0, 0, 0);
    }
    float mx = -INFINITY;
#pragma unroll
    for (int kb = 0; kb < NKB; ++kb) { const unsigned mh = mw[kb] >> (4 * h);
#pragma unroll
        for (int j = 0; j < 16; ++j) { const int t = __builtin_amdgcn_sbfe((int)mh, (j & 3) + 8 * (j >> 2), 1);
            const unsigned sb = (__float_as_uint(s[kb][j]) & (unsigned)t) | (~(unsigned)t & 0xff800000u); s[kb][j] = __uint_as_float(sb); mx = fmaxf(mx, s[kb][j]); } }
    mx = fmaxf(mx, __shfl_xor(mx, 32));
    if (__any(mx > mrun + 8.0f)) {
        const float mnew = fmaxf(mrun, mx); const float ms = (mnew == -INFINITY) ? 0.f : mnew;
        const float alpha = __builtin_amdgcn_exp2f(mrun - ms); mrun = mnew; lrun *= alpha;
#pragma unroll
        for (int db = 0; db < D / 32; ++db)
#pragma unroll
            for (int j = 0; j < 16; ++j) o[db][j] *= alpha;
    }
    const float msafe = (mrun == -INFINITY) ? 0.f : mrun;
    float ls = 0.f;
#pragma unroll
    for (int kb = 0; kb < NKB; ++kb)
#pragma unroll
        for (int j = 0; j < 16; ++j) { s[kb][j] = __builtin_amdgcn_exp2f(s[kb][j] - msafe); ls += s[kb][j]; }
    lrun += ls;
#pragma unroll
    for (int kb = 0; kb < NKB; ++kb) {
#pragma unroll
        for (int s2 = 0; s2 < 2; ++s2) {
            bf16x8 va[D / 32];
#pragma unroll
            for (int db = 0; db < D / 32; ++db) va[db] = *(const LAS bf16x8*)(Vt + (32 * db + r) * VS + (32 * kb + 16 * s2 + 8 * h) * 2);
            asm volatile("" ::: "memory");
            u32x4 pw; pw.x = pk_bf16(s[kb][8 * s2 + 0], s[kb][8 * s2 + 1]); pw.y = pk_bf16(s[kb][8 * s2 + 2], s[kb][8 * s2 + 3]); pw.z = pk_bf16(s[kb][8 * s2 + 4], s[kb][8 * s2 + 5]); pw.w = pk_bf16(s[kb][8 * s2 + 6], s[kb][8 * s2 + 7]);
            const bf16x8 pb = __builtin_bit_cast(bf16x8, pw);
#pragma unroll
            for (int db = 0; db < D / 32; ++db) o[db] = __builtin_amdgcn_mfma_f32_32x32x16_bf16(va[db], pb, o[db], 0, 0, 0);
        }
    }
}
template <int D, int SS> DI void attn_store(const f32x16 (&o)[D / 32], float inv, LAS unsigned char* stg, bf16_t* dst  , int nvalid, int lane_in) {
    int lane = lane_in; asm volatile("" : "+v"(lane));
    const int r = lane & 31, h = lane >> 5;
#pragma unroll
    for (int db = 0; db < D / 32; ++db)
#pragma unroll
        for (int g4 = 0; g4 < 4; ++g4) { u32x2 w; w.x = pk_bf16(o[db][4 * g4] * inv, o[db][4 * g4 + 1] * inv); w.y = pk_bf16(o[db][4 * g4 + 2] * inv, o[db][4 * g4 + 3] * inv);
            *(LAS u32x2*)(stg + r * SS + (32 * db + 8 * g4 + 4 * h) * 2) = w; }
    asm volatile("s_waitcnt lgkmcnt(0)" ::: "memory");
    constexpr int CPR = D / 8;
#pragma unroll
    for (int j = 0; j < (32 * CPR) / 64; ++j) { const int idx = lane + 64 * j, row = idx / CPR, ch = idx % CPR;
        const u32x4 v = *(const LAS u32x4*)(stg + row * SS + ch * 16); if (row < nvalid) *(u32x4*)(dst + (size_t)row * DM + ch * 8) = v; }
    asm volatile("s_waitcnt lgkmcnt(0)" ::: "memory");
}

DI void p_attn_a(Frame& F) {
    unsigned char* ws = F.ws; const int tid = F.tid, lane = F.lane, r = lane & 31, h = lane >> 5, w = F.wave, g = w & 3, qh = w >> 2;
    bf16_t* qo = (bf16_t*)(ws + O_QO); const bf16_t* kA = (const bf16_t*)(ws + O_KA); const bf16_t* vT = (const bf16_t*)(ws + O_VTA);
    const unsigned* maskbits = (const unsigned*)(ws + O_MASK);
    constexpr int KS = 272, VS = 144, KBYTES = 64 * KS, VBYTES = 128 * VS;
    LAS unsigned char* L = F.lds;
    constexpr int NUNITS = NB * 4 * 33;
    for (int i = 0;; ++i) {
        const int u = i * F.G + ((i & 1) ? (F.G - 1 - F.c) : F.c); if (u >= NUNITS) break;
        int tidl = tid; asm volatile("" : "+v"(tidl));
        const int qb = 32 - (u >> 5), bk = u & 31, b = bk >> 2, kvh = bk & 3;
        const int tq = qb * 64 + qh * 32 + r; const int tqc = tq < T ? tq : T - 1; const size_t mq = (size_t)b * T + tqc;
        bf16x8 qf[8];
        { int hh = h; asm volatile("" : "+v"(hh)); qprep128((const bf16_t*)(ws + O_R1) + mq * 3072 + (kvh * 4 + g) * 128, F.in(12), (float)tqc, hh, qf); }
        float mrun = -INFINITY, lrun = 0.f; f32x16 o[4];
#pragma unroll
        for (int db = 0; db < 4; ++db)
#pragma unroll
            for (int j = 0; j < 16; ++j) o[db][j] = 0.f;
        const int NT = qb + 1;
        const bf16_t* kg = kA + ((size_t)b * T) * 512 + kvh * 128; const bf16_t* vg = vT + ((size_t)(b * 4 + kvh) * 128) * TP;
        u32x4 kst[2], vst[2];
#define LOADT(kt) do { _Pragma("unroll") for (int p = 0; p < 2; ++p) { const int idx = tidl + 512 * p; \
            kst[p] = *(const u32x4*)(kg + ((size_t)(kt) * 64 + (idx >> 4)) * 512 + (idx & 15) * 8); \
            vst[p] = *(const u32x4*)(vg + (size_t)(idx >> 3) * TP + (kt) * 64 + (idx & 7) * 8); } } while (0)
#define WRITET(buf) do { _Pragma("unroll") for (int p = 0; p < 2; ++p) { const int idx = tidl + 512 * p; \
            *(LAS u32x4*)(L + (buf) * KBYTES + (idx >> 4) * KS + (idx & 15) * 16) = kst[p]; \
            *(LAS u32x4*)(L + 2 * KBYTES + (buf) * VBYTES + (idx >> 3) * VS + (idx & 7) * 16) = vst[p]; } } while (0)
        LOADT(0); u32x2 mk = *(const u32x2*)(maskbits + mq * MW);
        WRITET(0); __syncthreads();
        for (int kt = 0; kt < NT; ++kt) {
            u32x2 mkn = mk;
            if (kt + 1 < NT) { LOADT(kt + 1); mkn = *(const u32x2*)(maskbits + mq * MW + 2 * (kt + 1)); }
            const int buf = kt & 1;
            const LAS unsigned char* Kt = L + buf * KBYTES; const LAS unsigned char* Vt = L + 2 * KBYTES + buf * VBYTES;
            { const unsigned mw2[2] = {mk.x, mk.y}; attn_step<128, KS, VS, 2>(qf, Kt, Vt, mw2, mrun, lrun, o, r, h); }
            if (kt + 1 < NT) WRITET(buf ^ 1);
            __syncthreads();
            mk = mkn;
        }
#undef LOADT
#undef WRITET
        const float lt = lrun + __shfl_xor(lrun, 32); const float inv = 1.0f / lt;
        const int t0w = qb * 64 + qh * 32; const int nvalid = (T - t0w) < 32 ? (T - t0w) : 32;
        attn_store<128, 272>(o, inv, L + w * (32 * 272), qo + ((size_t)b * T + t0w) * DM + (kvh * 4 + g) * 128, nvalid, lane);
        __syncthreads();
    }
}

DI void p_post_kv(Frame& F) {
    unsigned char* ws = F.ws; const int lane = F.lane, l16 = lane & 15;
    const float* kvraw = (const float*)(ws + O_R1); bf16_t* kB = (bf16_t*)(ws + O_KB); bf16_t* vT = (bf16_t*)(ws + O_VTB);
    const int gw_ = F.cgw, NGW_ = F.cNGW;
    const f32x4 gk = *(const f32x4*)(F.in(18) + l16 * 4);
    float inv_i[4];
#pragma unroll
    for (int c = 0; c < 4; ++c) inv_i[c] = INV16[2 * ((lane & 1) * 4 + c)];
    f32x4 rk;
    int m = gw_; if (m < MP) rk = *(const f32x4*)(kvraw + (size_t)m * 512 + lane * 4);
    for (; m < MP; m += NGW_) {
        f32x4 v = rk;
        if (m + NGW_ < MP) rk = *(const f32x4*)(kvraw + (size_t)(m + NGW_) * 512 + lane * 4);
        const int b = m / T, t = m - b * T; const bool valid = m < M; const float tp = valid ? (float)t : 0.f;
        float csi[4], sni[4];
#pragma unroll
        for (int c = 0; c < 4; ++c) rope_cs(tp, inv_i[c], csi[c], sni[c]);
        head64_norm_rope<true>(v, gk, csi, sni, lane); store4_bf16(kB + (size_t)m * 256 + lane * 4, v, 1.0f);
    }
    vt_transpose<256, true>(F, kvraw, 512, 256, vT, gw_ / NWAVES, NGW_ / NWAVES);
    zero_vt_pad(F, vT, NB * 4 * 64, gw_, NGW_);
}
DI void p_post_qb(Frame& F) {
    unsigned char* ws = F.ws; const int lane = F.lane, l16 = lane & 15;
    const bf16_t* qraw = (const bf16_t*)(ws + O_R1); bf16_t* qo = (bf16_t*)(ws + O_QO);
    const f32x4 gq = *(const f32x4*)(F.in(21) + l16 * 4);
    float inv_i[4];
#pragma unroll
    for (int c = 0; c < 4; ++c) inv_i[c] = INV16[2 * ((lane & 1) * 4 + c)];
    u32x2 rq[8];
    int m = F.gw;
    if (m < MP) {
#pragma unroll
        for (int i = 0; i < 8; ++i) rq[i] = *(const u32x2*)(qraw + (size_t)m * DM + i * 256 + lane * 4); }
    for (; m < MP; m += F.NGW) {
        u32x2 cq[8];
#pragma unroll
        for (int i = 0; i < 8; ++i) cq[i] = rq[i];
        if (m + F.NGW < MP) {
#pragma unroll
            for (int i = 0; i < 8; ++i) rq[i] = *(const u32x2*)(qraw + (size_t)(m + F.NGW) * DM + i * 256 + lane * 4); }
        const int b = m / T, t = m - b * T; const bool valid = m < M; const float tp = valid ? (float)t : 0.f;
        float csi[4], sni[4];
#pragma unroll
        for (int c = 0; c < 4; ++c) rope_cs(tp, inv_i[c], csi[c], sni[c]);
#pragma unroll
        for (int it = 0; it < 8; ++it) { f32x4 v = unpack4(cq[it]); head64_norm_rope<true>(v, gq, csi, sni, lane); store4_bf16(qo + (size_t)m * DM + it * 256 + lane * 4, v, QSCALE_B); }
    }
}

DI void p_attn_b(Frame& F) {
    unsigned char* ws = F.ws; const int tid = F.tid, lane = F.lane, r = lane & 31, h = lane >> 5, w = F.wave;
    bf16_t* qo = (bf16_t*)(ws + O_QO); const bf16_t* kB = (const bf16_t*)(ws + O_KB); const bf16_t* vT = (const bf16_t*)(ws + O_VTB);
    const bf16_t* qraw = (const bf16_t*)(ws + O_R1);
    constexpr int KS = 144, VS = 336, KBYTES = 160 * KS, VBYTES = 64 * VS, SS = 144;
    LAS unsigned char* L = F.lds; LAS unsigned char* stg = L + KBYTES + VBYTES + w * (32 * SS);
    constexpr int NUNITS = NB * 4 * 65;
    u32x4 kst[3], vst[3], qst[4];
#define AB_LOAD(u_) do { const int qb_ = (u_) >> 5, bk_ = (u_) & 31, b_ = bk_ >> 2, kvh_ = bk_ & 3; const int kb0_ = qb_ >= 4 ? qb_ - 4 : 0; \
        const bf16_t* kg_ = kB + ((size_t)b_ * T + kb0_ * 32) * 256 + kvh_ * 64; const bf16_t* vg_ = vT + ((size_t)(b_ * 4 + kvh_) * 64) * TP + kb0_ * 32; \
        _Pragma("unroll") for (int p = 0; p < 3; ++p) { const int idx = tid + 512 * p; if (idx < 1280) { const int d_ = idx / 20, chn_ = idx - d_ * 20; \
            kst[p] = *(const u32x4*)(kg_ + (size_t)(idx >> 3) * 256 + (idx & 7) * 8); vst[p] = *(const u32x4*)(vg_ + (size_t)d_ * TP + chn_ * 8); } } \
        const int tq_ = qb_ * 32 + r; const int tqc_ = tq_ < T ? tq_ : T - 1; const bf16_t* qrow_ = qraw + ((size_t)b_ * T + tqc_) * DM + (kvh_ * 8 + w) * 64 + 8 * h; \
        _Pragma("unroll") for (int s_ = 0; s_ < 4; ++s_) qst[s_] = *(const u32x4*)(qrow_ + 16 * s_); } while (0)
    if (F.c < NUNITS) AB_LOAD(F.c);
    for (int i = 0;; ++i) {
        const int u = i * F.G + F.c; if (u >= NUNITS) break;
        const int qb = u >> 5, bk = u & 31, b = bk >> 2, kvh = bk & 3, head = kvh * 8 + w;
        const int kb0 = qb >= 4 ? qb - 4 : 0, nblk = qb - kb0 + 1;
#pragma unroll
        for (int p = 0; p < 3; ++p) { const int idx = tid + 512 * p; if (idx < 1280) { const int d = idx / 20, chn = idx - d * 20;
            *(LAS u32x4*)(L + (idx >> 3) * KS + (idx & 7) * 16) = kst[p]; *(LAS u32x4*)(L + KBYTES + d * VS + chn * 16) = vst[p]; } }
        const int tq = qb * 32 + r; const int tqc = tq < T ? tq : T - 1;
        bf16x8 qf[4];
        {
            int hh = h; asm volatile("" : "+v"(hh));
            float x[4][8]; float ss = 0.f;
#pragma unroll
            for (int s = 0; s < 4; ++s) { unpack8(qst[s], x[s]);
#pragma unroll
                for (int j = 0; j < 8; ++j) ss += x[s][j] * x[s][j]; }
            ss += __shfl_xor(ss, 32);
            const float rn = __builtin_amdgcn_rsqf(ss * (1.0f / 64.0f) + EPS); const float* gain = F.in(21);
#pragma unroll
            for (int s = 0; s < 4; ++s) { const f32x4 g0 = *(const f32x4*)(gain + 16 * s + 8 * hh), g1 = *(const f32x4*)(gain + 16 * s + 8 * hh + 4);
#pragma unroll
                for (int j = 0; j < 4; ++j) { x[s][j] *= rn * g0[j]; x[s][4 + j] *= rn * g1[j]; } }
#pragma unroll
            for (int j = 0; j < 8; ++j) { float cs, sn; rope_cs((float)tqc, INV16[2 * j], cs, sn); const float y = x[0][j]; const float p = __shfl_xor(y, 32); x[0][j] = hh ? (y * cs + p * sn) : (y * cs - p * sn); }
#pragma unroll
            for (int s = 0; s < 4; ++s) qf[s] = pack8(x[s], QSCALE_B);
        }
        float mrun = -INFINITY, lrun = 0.f; f32x16 o[2];
#pragma unroll
        for (int db = 0; db < 2; ++db)
#pragma unroll
            for (int j = 0; j < 16; ++j) o[db][j] = 0.f;
        __syncthreads();
        { const int un = u + F.G; if (un < NUNITS) AB_LOAD(un); }
        for (int j = 0; j < nblk; ++j) {
            const int hi = tqc - 32 * (kb0 + j), lo = hi - 127;
            const unsigned mhi = hi >= 31 ? 0xFFFFFFFFu : (hi < 0 ? 0u : ((2u << hi) - 1u));
            const unsigned mlo = lo <= 0 ? 0xFFFFFFFFu : (lo > 31 ? 0u : (0xFFFFFFFFu << lo));
            { const unsigned mw1[1] = {mhi & mlo}; attn_step<64, KS, VS, 1>(qf, L + (32 * j) * KS, L + KBYTES + 64 * j, mw1, mrun, lrun, o, r, h); }
        }
        const float sink2 = F.in(22)[head] * LOG2E;
        const float lt = lrun + __shfl_xor(lrun, 32); const float mf = fmaxf(mrun, sink2);
        const float e0 = __builtin_amdgcn_exp2f(mrun - mf); const float den = lt * e0 + __builtin_amdgcn_exp2f(sink2 - mf); const float inv = e0 / den;
        const int t0w = qb * 32; const int nvalid = (T - t0w) < 32 ? (T - t0w) : 32;
        attn_store<64, SS>(o, inv, stg, qo + ((size_t)b * T + t0w) * DM + head * 64, nvalid, lane);
        __syncthreads();
    }
#undef AB_LOAD
}

DI void p_tail_finalize(Frame& F, const float* part, int nch, float alpha, float* ss_out, bool fin) {
    unsigned char* ws = F.ws; bf16_t* hb = (bf16_t*)(ws + O_HB);
    typedef float f32x2 __attribute__((ext_vector_type(2)));
    for (int it = F.gw; it < 128 * 16; it += F.NGW) {
        const int r = it >> 4, seg = it & 15; const int row = 16384 + r; const size_t off = (size_t)row * DM + seg * 128 + F.lane * 2;
        f32x2 s = (f32x2){0.f, 0.f};
        for (int cix = 0; cix < nch; ++cix) s += *(const f32x2*)(part + ((size_t)cix * 128 + r) * DM + seg * 128 + F.lane * 2);
        const unsigned hw = *(const unsigned*)(hb + off);
        const f32x2 v = (f32x2){__uint_as_float(hw << 16), __uint_as_float(hw & 0xffff0000u)} + s * alpha;
        if (fin) { const int b = row / T, t = row - b * T; *(f32x2*)(F.out + ((size_t)(b * 2048 + t - 16)) * DM + seg * 128 + F.lane * 2) = v; }
        else { *(unsigned*)(hb + off) = pk_bf16(v[0], v[1]);
            const float sq = wave_sum(v[0] * v[0] + v[1] * v[1]); if (F.lane == 0) atomicAdd(ss_out + row, sq); }
    }
}

typedef __attribute__((address_space(1))) unsigned gu32;
#define XB_TMO      128
#define XB_XCNT(j)  (256  + 64 * (j))
#define XB_XSUB(j)  (1280 + 64 * (j))
#define XB_XGEN(j)  (2304 + 64 * (j))
#define XB_TOP      3328
#define XB_TOPGEN   3392
#define XCD_BAR_WORDS 3456
#define XB_SPIN_CAP (1u << 18)

__device__ __forceinline__ unsigned xb_ld(unsigned* p)              { return __hip_atomic_load(p, __ATOMIC_RELAXED, __HIP_MEMORY_SCOPE_AGENT); }
__device__ __forceinline__ unsigned xb_add(unsigned* p, unsigned v) { return __hip_atomic_fetch_add(p, v, __ATOMIC_RELAXED, __HIP_MEMORY_SCOPE_AGENT); }
__device__ __forceinline__ unsigned xb_xcc_id() { return (unsigned)__builtin_amdgcn_s_getreg((3 << 11) | 20) & 0xFu; }
#define XB_SPIN(cond, bar) do { unsigned _sp = 0; while (cond) { __builtin_amdgcn_s_sleep(1); \
    if ((++_sp & 255u) == 0u) { if (xb_ld(&(bar)[XB_TMO])) break; if (_sp > XB_SPIN_CAP) { atomicAdd(&(bar)[XB_TMO], 1u); break; } } } } while (0)

struct XcdBarrier {
    unsigned* bar; unsigned x;
    volatile LAS unsigned* st;
};

__device__ __forceinline__ XcdBarrier xcd_barrier_post(unsigned* bar, volatile LAS unsigned* st) {
    XcdBarrier b; b.bar = bar; b.x = xb_xcc_id(); b.st = st;
    if (threadIdx.x == 0) (void)xb_add(&bar[XB_XCNT(b.x)], 1u);
    return b;
}
__device__ __forceinline__ void xcd_barrier_complete(unsigned* bar, unsigned x, unsigned& nloc, unsigned& nx) {
    const unsigned G = gridDim.x * gridDim.y * gridDim.z;
    unsigned sum, cnt, mine, sp = 0u;
    for (;;) {
        sum = 0u; cnt = 0u; mine = 0u;
#pragma unroll
        for (unsigned j = 0; j < 16; ++j) { const unsigned c = xb_ld(&bar[XB_XCNT(j)]); sum += c; cnt += (c > 0u) ? 1u : 0u; mine = (j == x) ? c : mine; }
        if (sum == G) break;
        __builtin_amdgcn_s_sleep(1);
        if ((++sp & 255u) == 0u) { if (xb_ld(&bar[XB_TMO])) break; if (sp > XB_SPIN_CAP) { atomicAdd(&bar[XB_TMO], 1u); break; } }
    }
    nloc = mine > 0u ? mine : 1u; nx = cnt > 0u ? cnt : 1u;
}

__device__ __forceinline__ void xcd_barrier(const XcdBarrier& b) {
    asm volatile("s_waitcnt vmcnt(0)" ::: "memory");
    __syncthreads();
    if (threadIdx.x == 0) {
        unsigned* bar = b.bar;
        __builtin_amdgcn_s_waitcnt(0);
        unsigned nloc = b.st[0], nx = b.st[1];
        if (nloc == 0u) { xcd_barrier_complete(bar, b.x, nloc, nx); b.st[0] = nloc; b.st[1] = nx; }
        const unsigned old = xb_add(&bar[XB_XSUB(b.x)], 1u);
        const unsigned gen = old / nloc;
        if (old + 1u == (gen + 1u) * nloc) {
            __builtin_amdgcn_fence(__ATOMIC_RELEASE, "agent");
            asm volatile("s_waitcnt vmcnt(0)" ::: "memory");
            const unsigned og = xb_add(&bar[XB_TOP], 1u);
            const unsigned tg = og / nx;
            if (og + 1u == (tg + 1u) * nx) xb_add(&bar[XB_TOPGEN], 1u);
            else XB_SPIN(xb_ld(&bar[XB_TOPGEN]) == tg, bar);
            __builtin_amdgcn_fence(__ATOMIC_ACQUIRE, "agent");
            xb_add(&bar[XB_XGEN(b.x)], 1u);
            asm volatile("s_waitcnt vmcnt(0)" ::: "memory");
        } else {
            XB_SPIN(xb_ld(&bar[XB_XGEN(b.x)]) == gen, bar);
            __builtin_amdgcn_fence(__ATOMIC_ACQUIRE, "agent");
            asm volatile("s_waitcnt vmcnt(0)" ::: "memory");
        }
    }
    __syncthreads();
}

struct Args { const float* in[24]; float* out; unsigned char* ws; };
__global__ void __launch_bounds__(NWAVES * 64, 2) yoco_fwd(Args args) {
    extern __shared__ __attribute__((aligned(16))) unsigned char lds_raw[];
    cg::grid_group grid = cg::this_grid();
    if (threadIdx.x == 0) {
#pragma unroll
        for (int i = 0; i < 24; ++i) *(LAS unsigned long long*)((LAS unsigned char*)lds_raw + PTRTAB_OFF + 8 * i) = (unsigned long long)args.in[i];
    }
    if (threadIdx.x == 0) { *(LAS unsigned*)((LAS unsigned char*)lds_raw + PTRTAB_OFF + 192) = 0u; *(LAS unsigned*)((LAS unsigned char*)lds_raw + PTRTAB_OFF + 196) = 0u; }
    __syncthreads();
#ifndef DUP_MASK
#define DUP_MASK 0
#endif
    for (int step2 = 0; step2 < (DUP_MASK ? 40 : 20); ++step2) {
        const int step = DUP_MASK ? (step2 >> 1) : step2;
        size_t zoff = 0; asm volatile("" : "+s"(zoff));
        unsigned char* ws = (unsigned char*)((GAS unsigned char*)args.ws + zoff);
        int tid_ = threadIdx.x; asm volatile("" : "+v"(tid_));
#define GRID_BAR() do { XcdBarrier xb_; xb_.bar = (unsigned*)(ws + O_BAR); xb_.x = xb_xcc_id(); xb_.st = (volatile LAS unsigned*)((LAS unsigned char*)lds_raw + PTRTAB_OFF + 192); xcd_barrier(xb_); } while (0)
        Frame F;
        F.lds = (LAS unsigned char*)lds_raw; F.tid = tid_; F.lane = F.tid & 63; F.wave = __builtin_amdgcn_readfirstlane(F.tid >> 6);
        int G_ = gridDim.x, c_ = blockIdx.x; asm volatile("" : "+s"(G_), "+s"(c_));
        F.G = G_; F.c = c_; F.gw = F.c * NWAVES + F.wave; F.NGW = F.G * NWAVES; F.cgw = F.gw; F.cNGW = F.NGW; F.cnt_st = 0; F.cmode = 0;
        F.out = (float*)((GAS float*)args.out + zoff); F.ws = ws;
        float* ssb = (float*)(ws + O_SS); float* h = (float*)(ws + O_H); bf16_t* hb = (bf16_t*)(ws + O_HB); bf16_t* act = (bf16_t*)(ws + O_R1); bf16_t* qo = (bf16_t*)(ws + O_QO);
        bf16_t* WGUA = (bf16_t*)(ws + O_WGU_A); bf16_t* WDA = (bf16_t*)(ws + O_WD_A); bf16_t* WGUB = (bf16_t*)(ws + O_WGU_B); bf16_t* WDB = (bf16_t*)(ws + O_WD_B);
        int kind; const bf16_t* A = hb; const bf16_t* Bt = WGUA; int N = 2048, K = 2048; int ssi = 0, sso = 0; float alpha = 0.5f; bool fin = false;
        bf16_t* pb = nullptr; int ldb = 0, nbf = 0; float* pf = nullptr; int ldf = 0;
        switch (step) {
            case 0: kind = 0; break;
            case 1: kind = 1; Bt = WGUA; ssi = 0; break;
            case 2: kind = 2; A = act; Bt = WDA; K = DFF; sso = 1; break;
            case 3: kind = 3; Bt = (const bf16_t*)(ws + O_WIN); N = AINP; ssi = 1; pb = (bf16_t*)(ws + O_R1); ldb = 3072; nbf = 12; pf = (float*)(ws + O_PROJF); ldf = 1280; break;
            case 4: kind = 4; break;
            case 5: kind = 5; break;
            case 6: kind = 6; break;
            case 7: kind = 2; A = qo; Bt = (const bf16_t*)(ws + O_WOA); sso = 2; alpha = 1.0f; break;
            case 8: kind = 1; Bt = WGUB; ssi = 2; break;
            case 9: kind = 2; A = act; Bt = WDB; K = DFF; sso = 3; break;
            case 10: kind = 3; Bt = (const bf16_t*)(ws + O_WKV); N = 512; ssi = 3; pf = (float*)(ws + O_R1); ldf = 512; break;
            case 11: kind = 7; break;
            case 12: kind = 1; Bt = WGUA; ssi = 3; break;
            case 13: kind = 2; A = act; Bt = WDA; K = DFF; sso = 4; break;
            case 14: kind = 3; Bt = (const bf16_t*)(ws + O_WQB); N = 2048; ssi = 4; pb = (bf16_t*)(ws + O_R1); ldb = 2048; nbf = 8; break;
            case 15: kind = 11; break;
            case 16: kind = 9; break;
            case 17: kind = 2; A = qo; Bt = (const bf16_t*)(ws + O_WOB); sso = 5; alpha = 1.0f; break;
            case 18: kind = 1; Bt = WGUB; ssi = 5; break;
            default: kind = 2; A = act; Bt = WDB; K = DFF; sso = 6; fin = true; break;
        }
        if (DUP_MASK && (step2 & 1) && !((DUP_MASK >> kind) & 1)) continue;
        if (kind == 11) continue;
        if (kind == 0) p_prologue(F, step2 == 0);
        else if (kind == 1) { pg8::Gemm g{A, Bt, MP, 2 * DFF, 2048}; pg8::StaticOrder S; S.init(MP, 2 * DFF, F.G, F.c, 2048);
            pg8::EpiSwiglu E{act, ssb + (size_t)ssi * MP, (DUP_MASK && ((DUP_MASK >> 1) & 1) && !(step2 & 1)) ? 1ll : 0ll}; pg8::gemm_phase<pg8::EpiSwiglu, pg8::StaticOrder, true, true>(F.lds, g, S, E); }
        else if (kind == 2) { pg8::Gemm g{A, Bt, MP, 2048, K}; pg8::ResidOrder S; S.init(K, F.G, F.c);
            if (DUP_MASK && ((DUP_MASK >> 2) & 1) && !(step2 & 1)) { alpha = 0.f; sso = 7; fin = false; }
            float* part = (float*)(ws + O_H);
            pg8::EpiResid E{hb, ssb + (size_t)sso * MP, fin ? F.out : nullptr, part, alpha, S.ch}; pg8::gemm_phase<pg8::EpiResid, pg8::ResidOrder, true, true>(F.lds, g, S, E);
            GRID_BAR();
            p_tail_finalize(F, part, S.nch, alpha, ssb + (size_t)sso * MP, fin); }
        else if (kind == 3) { pg8::Gemm g{A, Bt, MP, N, 2048}; pg8::StaticOrder S; S.init(MP, N, F.G, F.c, 2048);
            pg8::EpiScale E{pb, pf, ssb + (size_t)ssi * MP, ldb, nbf, ldf, 0}; pg8::gemm_phase<pg8::EpiScale, pg8::StaticOrder, true, true>(F.lds, g, S, E);
            const int nwg = S.nwg, r0 = nwg - ((nwg - 1) / F.G) * F.G;
            if (step == 10 && !(DUP_MASK && (step2 & 1))) {
                if (F.c >= r0) { F.cmode = 1; F.cgw = (F.c - r0) * NWAVES + F.wave; F.cNGW = (F.G - r0) * NWAVES; }
                else { F.cmode = 2; F.cgw = F.c * NWAVES + F.wave; F.cNGW = r0 * NWAVES; }
                cvt_ffn(F, F.in(2), F.in(3), F.in(4), F.in(5), 1, WGUA, WDA);
            } else if (F.c >= r0 && !(DUP_MASK && (step2 & 1))) { F.cgw = (F.c - r0) * NWAVES + F.wave; F.cNGW = (F.G - r0) * NWAVES; F.cnt_st = 0;
                if (step == 3) cvt_ffn(F, F.in(6), F.in(7), F.in(8), F.in(9), 0, WGUB, WDB);
                else cvt_ffn(F, F.in(6), F.in(7), F.in(8), F.in(9), 1, WGUB, WDB); } }
        else if (kind == 4) p_post_a(F);
        else if (kind == 7) p_post_kv(F);
        else if (kind == 5) p_index(F);
        else if (kind == 6) p_attn_a(F);
        else if (kind == 8) p_post_qb(F);
        else p_attn_b(F);
        if (step2 == 0) { grid.sync(); (void)xcd_barrier_post((unsigned*)(ws + O_BAR), (volatile LAS unsigned*)((LAS unsigned char*)lds_raw + PTRTAB_OFF + 192)); }
        else if (step2 < (DUP_MASK ? 39 : 19)) GRID_BAR();
#ifdef EXTRA_SYNCS
        if (step2 == 0) for (int es = 0; es < EXTRA_SYNCS; ++es) GRID_BAR();
#endif
    }
}

extern "C" void kernel_launch(void* const* d_in, const int* in_sizes, int n_in, void* d_out, int out_size, void* d_ws, size_t ws_size, hipStream_t stream) {
    static int grid = 0;
    if (grid == 0) {
        if (n_in != 24 || ws_size < WS_END) { fprintf(stderr, "kernel_launch: expected 24 inputs and >= %zu bytes of workspace, got %d / %zu\n", (size_t)WS_END, n_in, ws_size); grid = -1; return; }
        int dev = 0, cus = 0, per_cu = 0;
        (void)hipGetDevice(&dev); (void)hipDeviceGetAttribute(&cus, hipDeviceAttributeMultiprocessorCount, dev);
        (void)hipFuncSetAttribute((const void*)yoco_fwd, hipFuncAttributeMaxDynamicSharedMemorySize, LDS_BYTES);
        if (hipOccupancyMaxActiveBlocksPerMultiprocessor(&per_cu, (const void*)yoco_fwd, NWAVES * 64, LDS_BYTES) != hipSuccess || per_cu < 1) per_cu = 1;
        (void)hipGetLastError();
        grid = cus * per_cu;
    }
    if (grid < 0) return;
    Args a{};
    for (int i = 0; i < 24; ++i) a.in[i] = (const float*)d_in[i];
    a.out = (float*)d_out; a.ws = (unsigned char*)d_ws;
    void* kargs[] = {&a};
    hipError_t e = hipLaunchCooperativeKernel((const void*)yoco_fwd, dim3(grid), dim3(NWAVES * 64), kargs, LDS_BYTES, stream);
    if (e != hipSuccess) fprintf(stderr, "cooperative launch failed: %s (grid %d)\n", hipGetErrorString(e), grid);
}
```
